# Optimizing an MI355X kernel written in HIP

```python
import jax
import jax.numpy as jnp
from jax import lax
import numpy as np

D_MODEL = 1024
BATCH = 2
SEQ = 8192
DEPTH = 2
DEC_BATCH = 128
DEC_SEQ = 8
PAST_LEN = 16384
PAGE_SIZE = 128

HEAD_DIM = 64
MIX_WIDTH = D_MODEL
GROUP_WIDTH = MIX_WIDTH // 4
RET_HEADS = GROUP_WIDTH // HEAD_DIM
RET_CHUNK = 128
ATTN_HEADS = GROUP_WIDTH // HEAD_DIM
ATTN_KV_HEADS = ATTN_HEADS // 2
ATTN_GROUP = ATTN_HEADS // ATTN_KV_HEADS
WINDOW = 128
ATTN_BLOCK = WINDOW
CONF_CH = GROUP_WIDTH
CONF_WIDTH = 31
SC_CH = GROUP_WIDTH
SC_WIDTH = 3
D_FF = 4 * D_MODEL
IN_WIDTH = 4 * GROUP_WIDTH + (ATTN_HEADS + 2 * ATTN_KV_HEADS) * HEAD_DIM + 2 * CONF_CH + 3 * SC_CH
EPS = 1e-6

kernel_name = 'hybrid_parallel_headgroup_decoder_step'


def _split_offsets():
    sizes = [GROUP_WIDTH] * 4 + [ATTN_HEADS * HEAD_DIM, ATTN_KV_HEADS * HEAD_DIM, ATTN_KV_HEADS * HEAD_DIM] + [CONF_CH] * 2 + [SC_CH] * 3
    offs, acc = [], 0
    for s in sizes[:-1]:
        acc += s
        offs.append(acc)
    return offs


def rms_norm(x, g):
    xf = x.astype(jnp.float32)
    y = xf * lax.rsqrt(jnp.mean(xf * xf, -1, keepdims=True) + EPS)
    return (y * g.astype(jnp.float32)).astype(x.dtype)


def layer_norm(x, g, b):
    xf = x.astype(jnp.float32)
    xc = xf - jnp.mean(xf, -1, keepdims=True)
    y = xc * lax.rsqrt(jnp.mean(xc * xc, -1, keepdims=True) + EPS)
    return (y * g.astype(jnp.float32) + b.astype(jnp.float32)).astype(x.dtype)


def alibi_slopes(n):
    return jnp.exp2(-8.0 * (jnp.arange(n, dtype=jnp.float32) + 1.0) / n)


def retention_log_decay(n):
    return jnp.log1p(-jnp.exp2(-5.0 - jnp.arange(n, dtype=jnp.float32)))


def retention(q, k, v, s0, chunk):
    b, l, h, dk = q.shape
    n_chunks = l // chunk
    log_g = retention_log_decay(h)
    i = jnp.arange(chunk, dtype=jnp.float32)
    diff = i[:, None] - i[None, :]
    intra = jnp.where(diff[None] >= 0, jnp.exp(jnp.maximum(diff, 0.0)[None] * log_g[:, None, None]), 0.0)
    q_dec = jnp.exp((i[:, None] + 1.0) * log_g[None, :])
    k_dec = jnp.exp((chunk - 1.0 - i)[:, None] * log_g[None, :])
    c_dec = jnp.exp(chunk * log_g)

    def to_chunks(t):
        return t.astype(jnp.float32).reshape(b, n_chunks, chunk, h, t.shape[-1]).transpose(1, 0, 2, 3, 4)

    qc, kc, vc = to_chunks(q), to_chunks(k * dk ** -0.5), to_chunks(v)

    def step(s, inp):
        qi, ki, vi = inp
        att = jnp.einsum('bihd,bjhd->bhij', qi, ki) * intra
        o = jnp.einsum('bhij,bjhe->bihe', att, vi) + jnp.einsum('bihd,bhde->bihe', qi * q_dec[None, :, :, None], s)
        s = s * c_dec[None, :, None, None] + jnp.einsum('bjhd,bjhe->bhde', ki * k_dec[None, :, :, None], vi)
        return s, o

    s, o = lax.scan(step, s0.astype(jnp.float32), (qc, kc, vc))
    return o.transpose(1, 0, 2, 3, 4).reshape(b, l, h, -1), s


def causal_dwconv(u, buf, w):
    width, ch = w.shape
    xp = jnp.concatenate([buf.astype(u.dtype), u], axis=1)
    y = lax.conv_general_dilated(xp, w.astype(u.dtype)[:, None, :], window_strides=(1,), padding='VALID',
                                 dimension_numbers=('NWC', 'WIO', 'NWC'), feature_group_count=ch)
    return y, xp[:, xp.shape[1] - (width - 1):]


def sink_attend(q, k, v, dist, valid, slopes, sinks):
    s = jnp.einsum('bnqhgd,bnkhd->bnhgqk', q, k).astype(jnp.float32) * HEAD_DIM ** -0.5
    s = s - slopes[:, :, None, None] * dist
    s = jnp.where(valid, s, -jnp.inf)
    sk = sinks.astype(jnp.float32)[:, :, None, None]
    m = jnp.maximum(jnp.max(s, -1, keepdims=True), sk)
    p = jnp.exp(s - m)
    p = p / (jnp.sum(p, -1, keepdims=True) + jnp.exp(sk - m))
    return jnp.einsum('bnhgqk,bnkhd->bnqhgd', p.astype(v.dtype), v)


def swa_prompt(q, k, v, slopes, sinks):
    b, n = q.shape[:2]
    nb = n // ATTN_BLOCK
    qb = q.reshape(b, nb, ATTN_BLOCK, ATTN_KV_HEADS, ATTN_GROUP, HEAD_DIM)

    def with_prev(t):
        tb = t.reshape(b, nb, ATTN_BLOCK, ATTN_KV_HEADS, HEAD_DIM)
        prev = jnp.concatenate([jnp.zeros_like(tb[:, :1]), tb[:, :-1]], axis=1)
        return jnp.concatenate([prev, tb], axis=2)

    iq = jnp.arange(ATTN_BLOCK)[:, None] + ATTN_BLOCK
    jk = jnp.arange(2 * ATTN_BLOCK)[None, :]
    dist = iq - jk
    band = (dist >= 0) & (dist <= WINDOW)
    has_prev = (jnp.arange(nb) > 0)[:, None, None] | (jk >= ATTN_BLOCK)[None]
    valid = (band[None] & has_prev)[:, None, None]
    o = sink_attend(qb, with_prev(k), with_prev(v), dist.astype(jnp.float32)[None, None, None], valid, slopes, sinks)
    return o.reshape(b, n, ATTN_HEADS * HEAD_DIM)


def swa_sample(q, k, v, k_buf, v_buf, slopes, sinks):
    b, n = q.shape[:2]
    wb = k_buf.shape[1]
    kk = jnp.concatenate([k_buf.astype(k.dtype), k], axis=1)
    vv = jnp.concatenate([v_buf.astype(v.dtype), v], axis=1)
    dist = (jnp.arange(n)[:, None] + wb) - jnp.arange(wb + n)[None, :]
    valid = (dist >= 0) & (dist <= WINDOW)
    o = sink_attend(q[:, None], kk[:, None], vv[:, None], dist.astype(jnp.float32)[None, None, None],
                    valid[None, None, None], slopes, sinks)
    return o.reshape(b, n, ATTN_HEADS * HEAD_DIM), kk[:, kk.shape[1] - wb:], vv[:, vv.shape[1] - wb:]


def decoder_layer(x, c, l, state, win_buf, prompt, wts):
    (ada_w, ada_b, norm1_g, norm2_g, w_in, q_norm_g, k_norm_g, attn_sinks,
     conf_dw, conf_ln_g, conf_ln_b, sconv_dw, w_out, w_ff1, w_ff2) = wts
    b, n, _ = x.shape
    mod = jax.nn.silu(c) @ ada_w[l] + ada_b[l]
    shift1, scale1, gate1, shift2, scale2, gate2 = jnp.split(mod, 6, axis=-1)

    h = rms_norm(x, norm1_g[l]) * (1.0 + scale1[:, None]) + shift1[:, None]
    z = h @ w_in[l]
    (r_q, r_k, r_v, r_g, a_q, a_k, a_v, c_a, c_b, s_b, s_c, s_h) = jnp.split(z, _split_offsets(), axis=-1)
    if prompt:
        ret_s0 = jnp.zeros((b, RET_HEADS, HEAD_DIM, HEAD_DIM), jnp.float32)
        conf_buf = jnp.zeros((b, CONF_WIDTH - 1, CONF_CH), x.dtype)
        sc_buf = jnp.zeros((b, SC_WIDTH - 1, SC_CH), x.dtype)
    else:
        ret_s0, k_buf, v_buf, conf_buf, sc_buf = state

    def to_heads(t):
        return t.reshape(b, n, -1, HEAD_DIM)
    ro, ret_s = retention(to_heads(r_q), to_heads(r_k), to_heads(r_v), ret_s0, RET_CHUNK if prompt else n)
    ro = ro - jnp.mean(ro, -1, keepdims=True)
    ro = ro * lax.rsqrt(jnp.mean(ro * ro, -1, keepdims=True) + EPS)
    out_a = ro.reshape(b, n, GROUP_WIDTH).astype(x.dtype) * jax.nn.silu(r_g)

    q = rms_norm(a_q.reshape(b, n, ATTN_KV_HEADS, ATTN_GROUP, HEAD_DIM), q_norm_g[l])
    k = rms_norm(a_k.reshape(b, n, ATTN_KV_HEADS, HEAD_DIM), k_norm_g[l])
    v = a_v.reshape(b, n, ATTN_KV_HEADS, HEAD_DIM)
    slopes = alibi_slopes(ATTN_HEADS).reshape(ATTN_KV_HEADS, ATTN_GROUP)
    sinks = attn_sinks[l].reshape(ATTN_KV_HEADS, ATTN_GROUP)
    if prompt:
        out_b = swa_prompt(q, k, v, slopes, sinks)
        k_new, v_new = k[:, n - win_buf:], v[:, n - win_buf:]
    else:
        out_b, k_new, v_new = swa_sample(q, k, v, k_buf, v_buf, slopes, sinks)

    c_y, conf_new = causal_dwconv(c_a * jax.nn.sigmoid(c_b), conf_buf, conf_dw[l])
    out_c = jax.nn.silu(layer_norm(c_y, conf_ln_g[l], conf_ln_b[l]))

    s_y, sc_new = causal_dwconv(s_c * s_h, sc_buf, sconv_dw[l])
    out_d = s_b * s_y

    mixed = jnp.concatenate([out_a, out_b, out_c, out_d], axis=-1) @ w_out[l]
    x = x + gate1[:, None] * mixed

    h2 = rms_norm(x, norm2_g[l]) * (1.0 + scale2[:, None]) + shift2[:, None]
    ff = jnp.square(jax.nn.relu(h2 @ w_ff1[l])) @ w_ff2[l]
    x = x + gate2[:, None] * ff
    return x, (ret_s.astype(x.dtype), k_new, v_new, conf_new, sc_new)


def setup_inputs(seed: int = 0) -> dict:
    key = jax.random.key(seed)
    ks = jax.random.split(key, 24)
    wb = min(WINDOW, PAST_LEN)

    def nrm(k, shape, s):
        return jax.random.normal(k, shape, jnp.float32) * s

    return {
        'x_prompt': nrm(ks[0], (BATCH, SEQ, D_MODEL), 1.0),
        'x_sample': nrm(ks[1], (DEC_BATCH, DEC_SEQ, D_MODEL), 1.0),
        'c_prompt': nrm(ks[2], (BATCH, D_MODEL), 1.0),
        'c_sample': nrm(ks[3], (DEC_BATCH, D_MODEL), 1.0),
        'state_ret': nrm(ks[4], (DEPTH, DEC_BATCH, RET_HEADS, HEAD_DIM, HEAD_DIM), 0.5),
        'cache_swa_k': nrm(ks[5], (DEPTH, DEC_BATCH, wb, ATTN_KV_HEADS, HEAD_DIM), 1.0),
        'cache_swa_v': nrm(ks[6], (DEPTH, DEC_BATCH, wb, ATTN_KV_HEADS, HEAD_DIM), 1.0),
        'state_conf': nrm(ks[7], (DEPTH, DEC_BATCH, CONF_WIDTH - 1, CONF_CH), 0.5),
        'state_sconv': nrm(ks[8], (DEPTH, DEC_BATCH, SC_WIDTH - 1, SC_CH), 1.0),
        'ada_w': nrm(ks[9], (DEPTH, D_MODEL, 6 * D_MODEL), 0.5 * D_MODEL ** -0.5),
        'ada_b': nrm(ks[10], (DEPTH, 6 * D_MODEL), 0.02),
        'norm1_g': 1.0 + nrm(ks[11], (DEPTH, D_MODEL), 0.02),
        'norm2_g': 1.0 + nrm(ks[12], (DEPTH, D_MODEL), 0.02),
        'w_in': nrm(ks[13], (DEPTH, D_MODEL, IN_WIDTH), D_MODEL ** -0.5),
        'q_norm_g': 1.0 + nrm(ks[14], (DEPTH, HEAD_DIM), 0.02),
        'k_norm_g': 1.0 + nrm(ks[15], (DEPTH, HEAD_DIM), 0.02),
        'attn_sinks': nrm(ks[16], (DEPTH, ATTN_HEADS), 0.5),
        'conf_dw': nrm(ks[17], (DEPTH, CONF_WIDTH, CONF_CH), CONF_WIDTH ** -0.5),
        'conf_ln_g': 1.0 + nrm(ks[18], (DEPTH, CONF_CH), 0.02),
        'conf_ln_b': nrm(ks[19], (DEPTH, CONF_CH), 0.02),
        'sconv_dw': nrm(ks[20], (DEPTH, SC_WIDTH, SC_CH), SC_WIDTH ** -0.5),
        'w_out': nrm(ks[21], (DEPTH, MIX_WIDTH, D_MODEL), MIX_WIDTH ** -0.5),
        'w_ff1': nrm(ks[22], (DEPTH, D_MODEL, D_FF), D_MODEL ** -0.5),
        'w_ff2': nrm(ks[23], (DEPTH, D_FF, D_MODEL), D_FF ** -0.5),
    }


def reference(x_prompt, x_sample, c_prompt, c_sample, state_ret, cache_swa_k, cache_swa_v, state_conf, state_sconv,
              ada_w, ada_b, norm1_g, norm2_g, w_in, q_norm_g, k_norm_g, attn_sinks,
              conf_dw, conf_ln_g, conf_ln_b, sconv_dw, w_out, w_ff1, w_ff2):
    wts = (ada_w, ada_b, norm1_g, norm2_g, w_in, q_norm_g, k_norm_g, attn_sinks,
           conf_dw, conf_ln_g, conf_ln_b, sconv_dw, w_out, w_ff1, w_ff2)
    win_buf = cache_swa_k.shape[2]

    y_prompt, prompt_states = x_prompt, []
    for l in range(DEPTH):
        y_prompt, st = decoder_layer(y_prompt, c_prompt, l, None, win_buf, True, wts)
        prompt_states.append(st)

    y_sample, sample_states = x_sample, []
    for l in range(DEPTH):
        st_in = (state_ret[l], cache_swa_k[l], cache_swa_v[l], state_conf[l], state_sconv[l])
        y_sample, st = decoder_layer(y_sample, c_sample, l, st_in, win_buf, False, wts)
        sample_states.append(st)

    def stack(sts, i):
        return jnp.stack([s[i] for s in sts])

    ret_p, k_p, v_p = stack(prompt_states, 0), stack(prompt_states, 1), stack(prompt_states, 2)
    conf_p, sconv_p = stack(prompt_states, 3), stack(prompt_states, 4)
    ret_s, k_s, v_s = stack(sample_states, 0), stack(sample_states, 1), stack(sample_states, 2)
    conf_s, sconv_s = stack(sample_states, 3), stack(sample_states, 4)
    return (y_prompt, y_sample, ret_p, k_p, v_p, conf_p, sconv_p, ret_s, k_s, v_s, conf_s, sconv_s)
```

```cpp
#include <hip/hip_runtime.h>
#include <hip/hip_cooperative_groups.h>
#include <cstdio>
#include <cstdint>
namespace cg = cooperative_groups;
namespace pg8 {
#define PG8_LAS __attribute__((address_space(3)))
typedef unsigned short bf16_t;
typedef short bf16x8 __attribute__((ext_vector_type(8)));
typedef float f32x4 __attribute__((ext_vector_type(4)));
typedef unsigned u32x4 __attribute__((ext_vector_type(4)));
constexpr int BM = 256, BK = 64, HALF = 128, HTB = HALF * BK * 2  , STAGE_BYTES = 8 * HTB, NXCD = 8, WGM = 8;

__host__ __device__ __forceinline__ int lds_byte(int r, int c) { const int st = (r >> 4) * 2 + (c >> 5), rr = r & 15, cc = c & 31, ob = rr * 64 + cc * 2; return st * 1024 + (ob ^ (((ob >> 9) & 1) << 5)); }
__host__ __device__ __forceinline__ void stage_rc(int b, int& R, int& C) { const int st = b / 1024, sb = b % 1024, swz = sb ^ (((sb >> 9) & 1) << 5); R = (st >> 1) * 16 + swz / 64; C = (st & 1) * 32 + (swz % 64) / 2; }
__host__ __device__ __forceinline__ int perm32(int rho) { const int n = rho >> 4, i = rho & 15; return 8 * (i >> 2) + 4 * n + (i & 3); }

struct Unit { int pm, pn; };
struct Gemm { const bf16_t* A; const bf16_t* Bt; int M, N, K; };

struct StaticOrder {
    int nM, nN, nwg, G, c;
    __host__ __device__ void init(int M, int N, int G_, int c_) { nM = M / BM; nN = N / BM; nwg = nM * nN; G = G_; c = c_; }
    __host__ __device__ bool next(int i, Unit& u) const {
        const long L = (long)i * G + c; if (L >= nwg) return false;
        int wgid = (int)L; { const int q = nwg / NXCD, r = nwg % NXCD, xcd = wgid % NXCD, off = wgid / NXCD; wgid = (xcd < r ? xcd * (q + 1) : r * (q + 1) + (xcd - r) * q) + off; }
        const int nig = WGM * nN, gid = wgid / nig, fm = gid * WGM, gsz = (nM - fm) < WGM ? (nM - fm) : WGM;
        u.pm = fm + ((wgid % nig) % gsz); u.pn = (wgid % nig) / gsz; return true;
    }
    __device__ __forceinline__ void a_ready(const Unit&) const {}
    __device__ __forceinline__ void done(const Unit&) const {}
};


__device__ __forceinline__ unsigned cvt_pk_bf16(float lo, float hi) { unsigned r; asm volatile("v_cvt_pk_bf16_f32 %0, %1, %2" : "=v"(r) : "v"(lo), "v"(hi)); return r; }

template <int ACT  > struct EpiBf16 {
    static constexpr bool PERM = true, AFTER_DRAIN = false;
    bf16_t* O; int ldc;
    __device__ __forceinline__ void operator()(const f32x4 (&acc)[2][2][4][2], const Unit& u, int wr, int wc, int fr, int fq) const {
        const int row0 = u.pm * BM + wr * 64 + fr; const int col0 = u.pn * BM + wc * 32 + 8 * fq;
#pragma unroll
        for (int ai = 0; ai < 2; ++ai)
#pragma unroll
            for (int m = 0; m < 4; ++m) { bf16_t* rowp = O + (size_t)(row0 + ai * HALF + m * 16) * ldc + col0;
#pragma unroll
                for (int bj = 0; bj < 2; ++bj) { f32x4 v0 = acc[ai][bj][m][0], v1 = acc[ai][bj][m][1];
                    if (ACT == 2) {
#pragma unroll
                        for (int e = 0; e < 4; ++e) { float a = fmaxf(v0[e], 0.f), b = fmaxf(v1[e], 0.f); v0[e] = a * a; v1[e] = b * b; }
                    }
                    u32x4 w; w.x = cvt_pk_bf16(v0[0], v0[1]); w.y = cvt_pk_bf16(v0[2], v0[3]); w.z = cvt_pk_bf16(v1[0], v1[1]); w.w = cvt_pk_bf16(v1[2], v1[3]);
                    *(u32x4*)(rowp + bj * HALF) = w; } }
    }
};

struct EpiRes {
    static constexpr bool PERM = false, AFTER_DRAIN = false;
    const float* baseP; const float* baseS; float* out; const float* gate; int ldc; int tprows; int gstride;
    __device__ __forceinline__ void operator()(const f32x4 (&acc)[2][2][4][2], const Unit& u, int wr, int wc, int fr, int fq) const {
        const int col0 = u.pn * BM + wc * 32 + 4 * fq;
#pragma unroll
        for (int ai = 0; ai < 2; ++ai)
#pragma unroll
            for (int m = 0; m < 4; ++m) {
                const int row = u.pm * BM + ai * HALF + wr * 64 + m * 16 + fr;
                const int gr = row < tprows ? (row >> 13) : 2 + ((row - tprows) >> 3);
                const float* gp = gate + (size_t)gr * gstride + col0;
                const float* bp = (row < tprows ? baseP + (size_t)row * ldc : baseS + (size_t)(row - tprows) * ldc) + col0;
                float* op = out + (size_t)row * ldc + col0;
#pragma unroll
                for (int bj = 0; bj < 2; ++bj)
#pragma unroll
                    for (int n = 0; n < 2; ++n) { const int c = bj * HALF + n * 16;
                        const f32x4 g = *(const f32x4*)(gp + c); const f32x4 b = *(const f32x4*)(bp + c);
                        *(f32x4*)(op + c) = b + g * acc[ai][bj][m][n]; }
                if (m & 1) asm volatile("" ::: "memory");
            }
    }
};
template <class Epi, class Sched, bool ALIGN_EPI = false, bool SP2 = false>
__device__ __forceinline__ void gemm_phase(PG8_LAS unsigned char* lds, const Gemm g, const Sched& S, const Epi& E) {
    int tid_l = threadIdx.x; asm volatile("" : "+v"(tid_l));
    const int tid = tid_l, wid = __builtin_amdgcn_readfirstlane(tid >> 6), lane = tid & 63, wr = wid >> 2, wc = wid & 3, fr = lane & 15, fq = lane >> 4;
    const int K = g.K, nt = K / BK;
    unsigned voffA[2], voffB[2];
#pragma unroll
    for (int i = 0; i < 2; ++i) { int R, C; stage_rc(tid * 16 + i * 8192, R, C); const int Rb = Epi::PERM ? ((R & ~31) + perm32(R & 31)) : R;
        voffA[i] = (unsigned)(R * K + C) * 2u; voffB[i] = (unsigned)(Rb * K + C) * 2u; }
    const size_t kstep = (size_t)(BK * 2);
    const size_t hstep = (size_t)HALF * K * 2;
    const size_t tstep = 2 * hstep;
    const unsigned ldsw = (unsigned)wid * 1024u;
    const int aoff = lds_byte(wr * 64 + fr, fq * 8), boff = lds_byte(wc * 32 + fr, fq * 8);
#define PG8_SA(b, h) (((b) * 2 + (h)) * HTB)
#define PG8_SB(b, h) ((4 + (b) * 2 + (h)) * HTB)
#define PG8_STAGE(bufoff, gbase, voff) do { _Pragma("unroll") for (int _i = 0; _i < 2; ++_i) \
        __builtin_amdgcn_global_load_lds((const unsigned*)((const char*)(gbase) + (voff)[_i]), (PG8_LAS unsigned*)(lds + (bufoff) + ldsw + _i * 8192), 16, 0, 0); } while (0)
#define PG8_LDA(dst, b, h) do { _Pragma("unroll") for (int m = 0; m < 4; ++m) _Pragma("unroll") for (int k = 0; k < 2; ++k) dst[m][k] = *(const PG8_LAS bf16x8*)(lds + PG8_SA(b, h) + aoff + m * 2048 + k * 1024); } while (0)
#define PG8_LDB(dst, b, h) do { _Pragma("unroll") for (int n = 0; n < 2; ++n) _Pragma("unroll") for (int k = 0; k < 2; ++k) dst[n][k] = *(const PG8_LAS bf16x8*)(lds + PG8_SB(b, h) + boff + n * 2048 + k * 1024); } while (0)
#define PG8_MMA(ai, bj, At, Bt) do { __builtin_amdgcn_s_setprio(1); _Pragma("unroll") for (int m = 0; m < 4; ++m) _Pragma("unroll") for (int n = 0; n < 2; ++n) _Pragma("unroll") for (int k = 0; k < 2; ++k) \
        acc[ai][bj][m][n] = __builtin_amdgcn_mfma_f32_16x16x32_bf16(Bt[n][k], At[m][k], acc[ai][bj][m][n], 0, 0, 0); __builtin_amdgcn_s_setprio(0); } while (0)
#define PG8_WAIT_V(n) asm volatile("s_waitcnt vmcnt(" #n ")" ::: "memory")
#define PG8_WAIT_L(n) asm volatile("s_waitcnt lgkmcnt(" #n ")" ::: "memory")
#define PG8_BAR __builtin_amdgcn_s_barrier()
#define PG8_SCHED __builtin_amdgcn_sched_barrier(0)
    Unit cur, nxt; int ui = 0;
    if (!S.next(0, cur)) return;
    f32x4 acc[2][2][4][2];
#pragma unroll
    for (int a = 0; a < 2; ++a)
#pragma unroll
        for (int b = 0; b < 2; ++b)
#pragma unroll
            for (int m = 0; m < 4; ++m)
#pragma unroll
                for (int n = 0; n < 2; ++n) acc[a][b][m][n] = (f32x4){0.f, 0.f, 0.f, 0.f};
    bf16x8 At[4][2], B0[2][2], B1[2][2];
    const char* cA = (const char*)g.A + (size_t)cur.pm * tstep; const char* cB = (const char*)g.Bt + (size_t)cur.pn * tstep;
    S.a_ready(cur);
    if constexpr (SP2) {
        PG8_STAGE(PG8_SB(0, 0), cB, voffB); PG8_STAGE(PG8_SB(0, 1), cB + hstep, voffB); PG8_STAGE(PG8_SA(0, 0), cA, voffA); PG8_STAGE(PG8_SA(0, 1), cA + hstep, voffA);
        if (wr == 1) PG8_BAR;
        PG8_WAIT_V(2); PG8_BAR;
        PG8_STAGE(PG8_SB(1, 0), cB + kstep, voffB); PG8_STAGE(PG8_SA(1, 0), cA + kstep, voffA); PG8_STAGE(PG8_SB(1, 1), cB + hstep + kstep, voffB);
        PG8_WAIT_V(6); PG8_BAR;
    } else {
        PG8_STAGE(PG8_SB(0, 0), cB, voffB); PG8_STAGE(PG8_SA(0, 0), cA, voffA); PG8_STAGE(PG8_SB(0, 1), cB + hstep, voffB); PG8_STAGE(PG8_SA(0, 1), cA + hstep, voffA);
        if (wr == 1) PG8_BAR;
        PG8_WAIT_V(4); PG8_BAR;
        PG8_STAGE(PG8_SB(1, 0), cB + kstep, voffB); PG8_STAGE(PG8_SA(1, 0), cA + kstep, voffA); PG8_STAGE(PG8_SB(1, 1), cB + hstep + kstep, voffB);
        PG8_WAIT_V(6); PG8_BAR;
    }
    for (;;) {
        const bool has_next = S.next(ui + 1, nxt);
        const char* nA = has_next ? (const char*)g.A + (size_t)nxt.pm * tstep : cA; const char* nB = has_next ? (const char*)g.Bt + (size_t)nxt.pn * tstep : cB;
        for (int t = 0; t < nt; t += 2) {
            const bool last = (t == nt - 2);
            const char* a1 = cA + (size_t)(t + 1) * kstep;
            const char* a2 = last ? nA : cA + (size_t)(t + 2) * kstep; const char* b2 = last ? nB : cB + (size_t)(t + 2) * kstep;
            const char* a3 = a2 + kstep; const char* b3 = b2 + kstep;
            if (last && has_next) S.a_ready(nxt);
            if constexpr (SP2) {
            PG8_LDB(B0, 0, 0); PG8_LDB(B1, 0, 1); PG8_SCHED; PG8_LDA(At, 0, 0); PG8_STAGE(PG8_SA(1, 1), a1 + hstep, voffA);
            PG8_WAIT_V(8); PG8_WAIT_L(0); PG8_BAR; PG8_MMA(0, 0, At, B0); PG8_MMA(0, 1, At, B1); PG8_BAR; PG8_SCHED;
            PG8_LDA(At, 0, 1); PG8_STAGE(PG8_SB(0, 0), b2, voffB); PG8_STAGE(PG8_SB(0, 1), b2 + hstep, voffB); PG8_STAGE(PG8_SA(0, 0), a2, voffA);
            PG8_WAIT_V(8); PG8_WAIT_L(0); PG8_BAR; PG8_MMA(1, 0, At, B0); PG8_MMA(1, 1, At, B1); PG8_BAR; PG8_SCHED;
            PG8_LDB(B0, 1, 0); PG8_LDB(B1, 1, 1); PG8_SCHED; PG8_LDA(At, 1, 0); PG8_STAGE(PG8_SA(0, 1), a2 + hstep, voffA);
            PG8_WAIT_V(8); PG8_WAIT_L(0); PG8_BAR; PG8_MMA(0, 0, At, B0); PG8_MMA(0, 1, At, B1); PG8_BAR; PG8_SCHED;
            PG8_LDA(At, 1, 1); PG8_STAGE(PG8_SB(1, 0), b3, voffB); PG8_STAGE(PG8_SB(1, 1), b3 + hstep, voffB); PG8_STAGE(PG8_SA(1, 0), a3, voffA);
            PG8_WAIT_V(8); PG8_WAIT_L(0); PG8_BAR; PG8_MMA(1, 0, At, B0); PG8_MMA(1, 1, At, B1); PG8_BAR; PG8_SCHED;
            } else {
            PG8_LDB(B0, 0, 0); PG8_SCHED; PG8_LDA(At, 0, 0); PG8_STAGE(PG8_SA(1, 1), a1 + hstep, voffA);
            PG8_WAIT_L(8); PG8_BAR; PG8_WAIT_L(0); PG8_MMA(0, 0, At, B0); PG8_BAR; PG8_SCHED;
            PG8_LDB(B1, 0, 1); PG8_STAGE(PG8_SB(0, 0), b2, voffB);
            PG8_BAR; PG8_WAIT_L(0); PG8_MMA(0, 1, At, B1); PG8_BAR;
            PG8_LDA(At, 0, 1); PG8_STAGE(PG8_SA(0, 0), a2, voffA);
            PG8_BAR; PG8_WAIT_L(0); PG8_MMA(1, 0, At, B0); PG8_BAR; PG8_SCHED;
            PG8_STAGE(PG8_SB(0, 1), b2 + hstep, voffB);
            PG8_WAIT_V(6); PG8_BAR; PG8_MMA(1, 1, At, B1); PG8_BAR;
            PG8_LDB(B0, 1, 0); PG8_SCHED; PG8_LDA(At, 1, 0); PG8_STAGE(PG8_SA(0, 1), a2 + hstep, voffA);
            PG8_WAIT_L(8); PG8_BAR; PG8_WAIT_L(0); PG8_MMA(0, 0, At, B0); PG8_BAR; PG8_SCHED;
            PG8_LDB(B1, 1, 1); PG8_STAGE(PG8_SB(1, 0), b3, voffB);
            PG8_BAR; PG8_WAIT_L(0); PG8_MMA(0, 1, At, B1); PG8_BAR;
            PG8_LDA(At, 1, 1); PG8_STAGE(PG8_SA(1, 0), a3, voffA);
            PG8_BAR; PG8_WAIT_L(0); PG8_MMA(1, 0, At, B0); PG8_BAR; PG8_SCHED;
            PG8_STAGE(PG8_SB(1, 1), b3 + hstep, voffB);
            PG8_WAIT_V(6); PG8_BAR; PG8_MMA(1, 1, At, B1); PG8_BAR;
            }
        }
        if constexpr (ALIGN_EPI) { if (wr == 0) PG8_BAR; }
        if constexpr (!Epi::AFTER_DRAIN) { E(acc, cur, wr, wc, fr, fq); S.done(cur); }
        if (!has_next) break;
#pragma unroll
        for (int a = 0; a < 2; ++a)
#pragma unroll
            for (int b = 0; b < 2; ++b)
#pragma unroll
                for (int m = 0; m < 4; ++m)
#pragma unroll
                    for (int n = 0; n < 2; ++n) acc[a][b][m][n] = (f32x4){0.f, 0.f, 0.f, 0.f};
        cur = nxt; cA = nA; cB = nB; ++ui;
        if constexpr (ALIGN_EPI) { if (wr == 1) PG8_BAR; }
    }
    PG8_WAIT_V(0);
    if constexpr (!ALIGN_EPI) { if (wr == 0) PG8_BAR; }
    PG8_BAR;
    if constexpr (Epi::AFTER_DRAIN) { E.fused(acc, cur, wr, wc, fr, fq, lds, wid, lane); S.done(cur); }
#undef PG8_SA
#undef PG8_SB
#undef PG8_STAGE
#undef PG8_LDA
#undef PG8_LDB
#undef PG8_MMA
#undef PG8_WAIT_V
#undef PG8_WAIT_L
#undef PG8_BAR
#undef PG8_SCHED
}
}

#define LAS __attribute__((address_space(3)))
typedef unsigned short bf16;
typedef short bf16x8 __attribute__((ext_vector_type(8)));
typedef float f32x4 __attribute__((ext_vector_type(4)));
typedef unsigned u32x4 __attribute__((ext_vector_type(4)));
typedef unsigned u32x2 __attribute__((ext_vector_type(2)));

constexpr int NTHR = 512;
constexpr int D = 1024, SEQ = 8192, TP = 16384, TS = 1024, T = TP + TS, INW = 2816, FF = 4096, NL = 2;
constexpr int MODW = 6 * D, NMODR = 130;
constexpr float EPS = 1e-6f;
constexpr int ZC_RQ = 0, ZC_RK = 256, ZC_RV = 512, ZC_RG = 768, ZC_AQ = 1024, ZC_AK = 1280, ZC_AV = 1408, ZC_CA = 1536, ZC_CB = 1792, ZC_SB = 2048, ZC_SC = 2304, ZC_SH = 2560;
constexpr size_t O_YP = 0, O_YS = (size_t)TP * D, O_RETP = O_YS + (size_t)TS * D, O_KP = O_RETP + 2 * 2 * 4 * 4096, O_VP = O_KP + 2 * 2 * 128 * 128,
                 O_CONFP = O_VP + 2 * 2 * 128 * 128, O_SCP = O_CONFP + 2 * 2 * 30 * 256, O_RETS = O_SCP + 2 * 2 * 2 * 256, O_KS = O_RETS + (size_t)2 * 128 * 4 * 4096,
                 O_VS = O_KS + (size_t)2 * 128 * 128 * 128, O_CONFS = O_VS + (size_t)2 * 128 * 128 * 128, O_SCS = O_CONFS + (size_t)2 * 128 * 30 * 256, O_END = O_SCS + (size_t)2 * 128 * 2 * 256;
static_assert(O_END == 32735232, "output size");
constexpr size_t MiB = 1u << 20;
constexpr size_t WS_WIN = 0, WS_WOUT = 12 * MiB, WS_W1 = 16 * MiB, WS_W2 = 32 * MiB, WS_MOD = 48 * MiB, WS_XN = 56 * MiB, WS_H = 90 * MiB,
                 WS_Z = 90 * MiB, WS_MIX = 184 * MiB, WS_KV = 218 * MiB, WS_END = 226 * MiB;
static_assert((size_t)NL * INW * D * 2 <= WS_WOUT && (size_t)NL * NMODR * MODW * 4 <= 8 * MiB && WS_XN + (size_t)T * D * 2 <= WS_H && WS_Z + (size_t)T * INW * 2 <= WS_MIX &&
              WS_MIX + (size_t)T * D * 2 <= WS_KV && WS_KV + (size_t)2 * 4 * 64 * 4096 * 4 <= WS_END && WS_H + (size_t)T * FF * 2 <= WS_END, "ws map");
constexpr int LDS_BYTES = 147456;

struct Args { const float* in[24]; float* out; unsigned char* ws; };
enum { I_XP = 0, I_XS, I_CP, I_CS, I_SRET, I_CK, I_CV, I_SCONF, I_SSC, I_ADAW, I_ADAB, I_N1G, I_N2G, I_WIN, I_QG, I_KG, I_SINK, I_CDW, I_CLG, I_CLB, I_SDW, I_WOUT, I_WFF1, I_WFF2 };

__device__ __forceinline__ unsigned f2bf(float f) { unsigned u = __builtin_bit_cast(unsigned, f); return (u + 0x7fffu + ((u >> 16) & 1u)) >> 16; }
__device__ __forceinline__ unsigned pk2(float lo, float hi) { return f2bf(lo) | (f2bf(hi) << 16); }
__device__ __forceinline__ float bflo(unsigned u) { return __builtin_bit_cast(float, u << 16); }
__device__ __forceinline__ float bfhi(unsigned u) { return __builtin_bit_cast(float, u & 0xffff0000u); }
#define UNPACK8(raw, f) do { f[0] = bflo(raw.x); f[1] = bfhi(raw.x); f[2] = bflo(raw.y); f[3] = bfhi(raw.y); f[4] = bflo(raw.z); f[5] = bfhi(raw.z); f[6] = bflo(raw.w); f[7] = bfhi(raw.w); } while (0)
#define PACK8(f) ((u32x4){pk2(f[0], f[1]), pk2(f[2], f[3]), pk2(f[4], f[5]), pk2(f[6], f[7])})
#define LDS_WAIT() asm volatile("s_waitcnt lgkmcnt(0)" ::: "memory")
#define MFMA16(a, b, c) __builtin_amdgcn_mfma_f32_16x16x32_bf16((a), (b), (c), 0, 0, 0)
__device__ __forceinline__ float wave_sum(float v) {
#pragma unroll
    for (int o = 1; o < 64; o <<= 1) v += __shfl_xor(v, o);
    return v;
}
__device__ __forceinline__ float wave_max(float v) {
#pragma unroll
    for (int o = 1; o < 64; o <<= 1) v = fmaxf(v, __shfl_xor(v, o));
    return v;
}
__device__ __forceinline__ float sigmoidf_(float x) { return 1.f / (1.f + __expf(-x)); }
__device__ __forceinline__ float log2gamma(int h) { return log2f(1.f - exp2f(-5.f - (float)h)); }

__device__ __forceinline__ void p0_transpose_item(const float* W, int K, int N, bf16* WT, LAS float* scr, int item, int lane) {
    const int nblk = N / 32, kb = item / nblk, nb = item % nblk, k0 = 64 * kb, n0 = 32 * nb;
#pragma unroll 8
    for (int i = 0; i < 32; ++i) { const int kk = 2 * i + (lane >> 5); scr[kk * 33 + (lane & 31)] = W[(size_t)(k0 + kk) * N + n0 + (lane & 31)]; }
    LDS_WAIT();
    const int c = lane & 7;
#pragma unroll
    for (int j = 0; j < 4; ++j) { const int n = (lane >> 3) + 8 * j; const LAS float* s = scr + (8 * c) * 33 + n;
        u32x4 o; o.x = pk2(s[0 * 33], s[1 * 33]); o.y = pk2(s[2 * 33], s[3 * 33]); o.z = pk2(s[4 * 33], s[5 * 33]); o.w = pk2(s[6 * 33], s[7 * 33]);
        *(u32x4*)(WT + (size_t)(n0 + n) * K + k0 + 8 * c) = o; }
    LDS_WAIT();
}

__device__ __forceinline__ void p0_mod_item(LAS unsigned char* lds, const Args& A, int item, int tid) {
    asm volatile("" : "+v"(tid));
    const int l = item / 96, cb = item % 96, col0 = cb * 64;
    const int lane = tid & 63, w = tid >> 6, li = lane & 15, lq = lane >> 4;
    LAS bf16* Wt = (LAS bf16*)lds;
    LAS bf16* SC = (LAS bf16*)(lds + 64 * 264 * 2);
    const float* aw = A.in[I_ADAW] + (size_t)l * D * MODW;
    const int ct = w & 3, rg = w >> 2;
    f32x4 acc[5];
#pragma unroll
    for (int i = 0; i < 5; ++i) acc[i] = (f32x4){0.f, 0.f, 0.f, 0.f};
    for (int kc = 0; kc < 4; ++kc) {
        const int k0 = kc * 256;
        for (int i = 0; i < 32; ++i) { const int kk = (tid >> 6) + 8 * i, c = tid & 63;
            Wt[c * 264 + kk] = (bf16)f2bf(aw[(size_t)(k0 + kk) * MODW + col0 + c]); }
        for (int i = 0; i < 72; ++i) { const int idx = tid + 512 * i, r = idx >> 8, kk = idx & 255;
            float v = 0.f;
            if (r < NMODR) { const float c = (r < 2) ? A.in[I_CP][r * D + k0 + kk] : A.in[I_CS][(size_t)(r - 2) * D + k0 + kk]; v = c * sigmoidf_(c); }
            SC[r * 264 + kk] = (bf16)f2bf(v); }
        __syncthreads();
#pragma unroll
        for (int ks = 0; ks < 8; ++ks) {
            const bf16x8 wf = *(const LAS bf16x8*)(Wt + (ct * 16 + li) * 264 + ks * 32 + lq * 8);
#pragma unroll
            for (int mi = 0; mi < 5; ++mi) { const int mt = rg * 5 + mi;
                if (mt < 9) { const bf16x8 sf = *(const LAS bf16x8*)(SC + (mt * 16 + li) * 264 + ks * 32 + lq * 8); acc[mi] = MFMA16(wf, sf, acc[mi]); } }
        }
        __syncthreads();
    }
    float* mod = (float*)(A.ws + WS_MOD) + (size_t)l * NMODR * MODW;
    const int col = col0 + ct * 16 + lq * 4;
    const f32x4 bias = *(const f32x4*)(A.in[I_ADAB] + (size_t)l * MODW + col);
#pragma unroll
    for (int mi = 0; mi < 5; ++mi) { const int r = (rg * 5 + mi) * 16 + li;
        if (rg * 5 + mi < 9 && r < NMODR) *(f32x4*)(mod + (size_t)r * MODW + col) = acc[mi] + bias; }
}

__device__ __forceinline__ void p0_prologue(LAS unsigned char* lds, const Args& A, int tid) {
    asm volatile("" : "+v"(tid));
    const int G = gridDim.x, bx = blockIdx.x;
    for (int it = bx; it < 192; it += G) p0_mod_item(lds, A, it, tid);
    __syncthreads();
    const int lane = tid & 63, wave = tid >> 6;
    LAS float* scr = (LAS float*)(lds + wave * 16384);
    const int gw = bx * 8 + wave, NGW = G * 8;
    constexpr int I_IN = (D / 64) * (INW / 32), I_O = (D / 64) * (D / 32), I_1 = (D / 64) * (FF / 32), I_2 = (FF / 64) * (D / 32);
    constexpr int PER_L = I_IN + I_O + I_1 + I_2;
    for (int it = gw; it < NL * PER_L; it += NGW) {
        const int l = it / PER_L; int r = it % PER_L;
        if (r < I_IN) { p0_transpose_item(A.in[I_WIN] + (size_t)l * D * INW, D, INW, (bf16*)(A.ws + WS_WIN) + (size_t)l * INW * D, scr, r, lane); continue; } r -= I_IN;
        if (r < I_O) { p0_transpose_item(A.in[I_WOUT] + (size_t)l * D * D, D, D, (bf16*)(A.ws + WS_WOUT) + (size_t)l * D * D, scr, r, lane); continue; } r -= I_O;
        if (r < I_1) { p0_transpose_item(A.in[I_WFF1] + (size_t)l * D * FF, D, FF, (bf16*)(A.ws + WS_W1) + (size_t)l * FF * D, scr, r, lane); continue; } r -= I_1;
        p0_transpose_item(A.in[I_WFF2] + (size_t)l * FF * D, FF, D, (bf16*)(A.ws + WS_W2) + (size_t)l * D * FF, scr, r, lane);
    }
}

__device__ __forceinline__ void norm_phase(const Args& A, int l, int which  , int tid) {
    asm volatile("" : "+v"(tid));
    const int lane = tid & 63, wave = tid >> 6;
    const int gw = blockIdx.x * 8 + wave, NGW = gridDim.x * 8;
    const float* gptr = A.in[which ? I_N2G : I_N1G] + (size_t)l * D;
    const float* mod = (const float*)(A.ws + WS_MOD) + (size_t)l * NMODR * MODW + (which ? 3 * D : 0);
    bf16* XN = (bf16*)(A.ws + WS_XN);
    f32x4 g[4];
#pragma unroll
    for (int j = 0; j < 4; ++j) g[j] = *(const f32x4*)(gptr + 4 * lane + 256 * j);
    for (int m = gw; m < T; m += NGW) {
        const float* xr; int r;
        if (m < TP) { r = m >> 13; xr = (l == 0 && which == 0) ? A.in[I_XP] + (size_t)m * D : A.out + (size_t)m * D; }
        else { r = 2 + ((m - TP) >> 3); xr = (l == 0 && which == 0) ? A.in[I_XS] + (size_t)(m - TP) * D : A.out + (size_t)m * D; }
        const float* mr = mod + (size_t)r * MODW;
        f32x4 v[4]; float s = 0.f;
#pragma unroll
        for (int j = 0; j < 4; ++j) { v[j] = *(const f32x4*)(xr + 4 * lane + 256 * j); s += (v[j].x * v[j].x + v[j].y * v[j].y) + (v[j].z * v[j].z + v[j].w * v[j].w); }
        const float rstd = rsqrtf(wave_sum(s) * (1.f / D) + EPS);
#pragma unroll
        for (int j = 0; j < 4; ++j) {
            const f32x4 sh = *(const f32x4*)(mr + 4 * lane + 256 * j), sc = *(const f32x4*)(mr + D + 4 * lane + 256 * j);
            const f32x4 o = v[j] * rstd * g[j] * (sc + 1.f) + sh;
            u32x2 pk; pk.x = pk2(o.x, o.y); pk.y = pk2(o.z, o.w);
            *(u32x2*)(XN + (size_t)m * D + 4 * lane + 256 * j) = pk;
        }
    }
}

__device__ __forceinline__ void attn_unit(LAS unsigned char* lds, const Args& A, int l, int unit, int tid) {
    asm volatile("" : "+v"(tid));
    const int qh = unit & 3, nb = (unit >> 2) & 63, b = unit >> 8, kvh = qh >> 1;
    const int lane = tid & 63, w = tid >> 6, li = lane & 15, lq = lane >> 4;
    const bf16* Z = (const bf16*)(A.ws + WS_Z);
    bf16* MIX = (bf16*)(A.ws + WS_MIX);
    LAS bf16* Qs = (LAS bf16*)lds;
    LAS bf16* Ks = (LAS bf16*)(lds + 18432);
    LAS bf16* Vt = (LAS bf16*)(lds + 18432 + 36864);
    LAS bf16* Ps = (LAS bf16*)(lds + 18432 + 36864 + 35840) + w * (16 * 168);
    const long rowbase = (long)b * SEQ + (long)nb * 128;
    const float* qg = A.in[I_QG] + l * 64; const float* kg = A.in[I_KG] + l * 64;
    const bool wr_state = (nb == 63) && ((qh & 1) == 0);
#pragma unroll
    for (int i = 0; i < 2; ++i) {
        const int c = tid + 512 * i, r = c >> 3, p = c & 7;
        const u32x4 raw = *(const u32x4*)(Z + (size_t)(rowbase + r) * INW + ZC_AQ + qh * 64 + p * 8);
        float f[8]; UNPACK8(raw, f);
        float ss = 0.f;
#pragma unroll
        for (int e = 0; e < 8; ++e) ss += f[e] * f[e];
        ss += __shfl_xor(ss, 1); ss += __shfl_xor(ss, 2); ss += __shfl_xor(ss, 4);
        const float rs = rsqrtf(ss * (1.f / 64.f) + EPS) * 0.125f;
#pragma unroll
        for (int e = 0; e < 8; ++e) f[e] = f[e] * rs * qg[p * 8 + e];
        *(LAS u32x4*)(Qs + r * 72 + p * 8) = PACK8(f);
    }
#pragma unroll
    for (int i = 0; i < 4; ++i) {
        const int c = tid + 512 * i, r = c >> 3, p = c & 7;
        const bool valid = (nb > 0) || (r >= 128);
        u32x4 rk = (u32x4){0u, 0u, 0u, 0u}, rv = (u32x4){0u, 0u, 0u, 0u};
        if (valid) { const bf16* zr = Z + (size_t)(rowbase - 128 + r) * INW; rk = *(const u32x4*)(zr + ZC_AK + kvh * 64 + p * 8); rv = *(const u32x4*)(zr + ZC_AV + kvh * 64 + p * 8); }
        float f[8]; UNPACK8(rk, f);
        float ss = 0.f;
#pragma unroll
        for (int e = 0; e < 8; ++e) ss += f[e] * f[e];
        ss += __shfl_xor(ss, 1); ss += __shfl_xor(ss, 2); ss += __shfl_xor(ss, 4);
        const float rs = rsqrtf(ss * (1.f / 64.f) + EPS);
#pragma unroll
        for (int e = 0; e < 8; ++e) f[e] = f[e] * rs * kg[p * 8 + e];
        *(LAS u32x4*)(Ks + r * 72 + p * 8) = PACK8(f);
        float fv[8]; UNPACK8(rv, fv);
#pragma unroll
        for (int e = 0; e < 8; ++e) Vt[(p * 8 + e) * 280 + r] = (bf16)f2bf(fv[e]);
        if (wr_state && r >= 128) {
            float* kp = A.out + O_KP + ((size_t)((l * 2 + b) * 128 + (r - 128)) * 2 + kvh) * 64 + p * 8;
            float* vp = A.out + O_VP + ((size_t)((l * 2 + b) * 128 + (r - 128)) * 2 + kvh) * 64 + p * 8;
            *(f32x4*)kp = (f32x4){f[0], f[1], f[2], f[3]}; *(f32x4*)(kp + 4) = (f32x4){f[4], f[5], f[6], f[7]};
            *(f32x4*)vp = (f32x4){fv[0], fv[1], fv[2], fv[3]}; *(f32x4*)(vp + 4) = (f32x4){fv[4], fv[5], fv[6], fv[7]};
        }
    }
    for (int idx = tid; idx < 64 * 24; idx += NTHR) { const int row = idx / 24, c = 256 + idx % 24; Vt[row * 280 + c] = 0; }
    __syncthreads();
    bf16x8 qf[2];
#pragma unroll
    for (int kk = 0; kk < 2; ++kk) qf[kk] = *(const LAS bf16x8*)(Qs + (16 * w + li) * 72 + kk * 32 + lq * 8);
    f32x4 s[9];
#pragma unroll
    for (int nt = 0; nt < 9; ++nt) { s[nt] = (f32x4){0.f, 0.f, 0.f, 0.f};
#pragma unroll
        for (int kk = 0; kk < 2; ++kk) { const bf16x8 kf = *(const LAS bf16x8*)(Ks + (16 * (w + nt) + li) * 72 + kk * 32 + lq * 8); s[nt] = MFMA16(kf, qf[kk], s[nt]); } }
    const float slope = exp2f(-2.f * (float)(qh + 1)), sink = A.in[I_SINK][l * 4 + qh];
    float mx = sink;
#pragma unroll
    for (int nt = 0; nt < 9; ++nt)
#pragma unroll
        for (int r = 0; r < 4; ++r) {
            const int dist = 128 + li - 16 * nt - lq * 4 - r, jk = 16 * (w + nt) + lq * 4 + r;
            const bool ok = dist >= 0 && dist <= 128 && (nb > 0 || jk >= 128);
            const float v = ok ? s[nt][r] - slope * (float)dist : -INFINITY;
            s[nt][r] = v; mx = fmaxf(mx, v);
        }
    mx = fmaxf(mx, __shfl_xor(mx, 16)); mx = fmaxf(mx, __shfl_xor(mx, 32));
    float sum = 0.f;
#pragma unroll
    for (int nt = 0; nt < 9; ++nt)
#pragma unroll
        for (int r = 0; r < 4; ++r) { const float p = __expf(s[nt][r] - mx); s[nt][r] = p; sum += p; }
    sum += __shfl_xor(sum, 16); sum += __shfl_xor(sum, 32);
    const float inv = 1.f / (sum + __expf(sink - mx));
#pragma unroll
    for (int nt = 0; nt < 9; ++nt) { u32x2 pk; pk.x = pk2(s[nt][0] * inv, s[nt][1] * inv); pk.y = pk2(s[nt][2] * inv, s[nt][3] * inv);
        *(LAS u32x2*)(Ps + li * 168 + 16 * nt + lq * 4) = pk; }
    *(LAS u32x2*)(Ps + li * 168 + 144 + lq * 4) = (u32x2){0u, 0u};
    LDS_WAIT();
    f32x4 o[4];
#pragma unroll
    for (int dt = 0; dt < 4; ++dt) o[dt] = (f32x4){0.f, 0.f, 0.f, 0.f};
#pragma unroll
    for (int ks = 0; ks < 5; ++ks) { const bf16x8 pf = *(const LAS bf16x8*)(Ps + li * 168 + ks * 32 + lq * 8);
#pragma unroll
        for (int dt = 0; dt < 4; ++dt) { const bf16x8 vf = *(const LAS bf16x8*)(Vt + (16 * dt + li) * 280 + 16 * w + ks * 32 + lq * 8); o[dt] = MFMA16(vf, pf, o[dt]); } }
    bf16* orow = MIX + (size_t)(rowbase + 16 * w + li) * D + 256 + qh * 64 + lq * 4;
#pragma unroll
    for (int dt = 0; dt < 4; ++dt) { u32x2 pk; pk.x = pk2(o[dt][0], o[dt][1]); pk.y = pk2(o[dt][2], o[dt][3]); *(u32x2*)(orow + 16 * dt) = pk; }
    __syncthreads();
}

__device__ __forceinline__ void retkv_unit(LAS unsigned char* lds, const Args& A, int unit, int tid) {
    asm volatile("" : "+v"(tid));
    const int c = unit & 63, h = (unit >> 6) & 3, b = unit >> 8;
    const int lane = tid & 63, w = tid >> 6, li = lane & 15, lq = lane >> 4;
    const bf16* Z = (const bf16*)(A.ws + WS_Z);
    float* KV = (float*)(A.ws + WS_KV) + (size_t)((b * 4 + h) * 64 + c) * 4096;
    LAS bf16* Kt = (LAS bf16*)lds;
    LAS bf16* Vt = (LAS bf16*)(lds + 64 * 136 * 2);
    const size_t rowbase = (size_t)b * SEQ + (size_t)c * 128;
    const float l2g = log2gamma(h);
#pragma unroll
    for (int i = 0; i < 2; ++i) {
        const int ci = tid + 512 * i, j = ci >> 3, p = ci & 7;
        const bf16* zr = Z + (rowbase + j) * INW;
        const u32x4 rk = *(const u32x4*)(zr + ZC_RK + h * 64 + p * 8), rv = *(const u32x4*)(zr + ZC_RV + h * 64 + p * 8);
        float fk[8], fv[8]; UNPACK8(rk, fk); UNPACK8(rv, fv);
        const float sc = 0.125f * exp2f((float)(127 - j) * l2g);
#pragma unroll
        for (int e = 0; e < 8; ++e) { Kt[(p * 8 + e) * 136 + j] = (bf16)f2bf(fk[e] * sc); Vt[(p * 8 + e) * 136 + j] = (bf16)f2bf(fv[e]); }
    }
    __syncthreads();
    const int dtile = w & 3, eh = w >> 2;
    f32x4 acc[2] = {(f32x4){0.f, 0.f, 0.f, 0.f}, (f32x4){0.f, 0.f, 0.f, 0.f}};
#pragma unroll
    for (int ks = 0; ks < 4; ++ks) { const bf16x8 kf = *(const LAS bf16x8*)(Kt + (16 * dtile + li) * 136 + ks * 32 + lq * 8);
#pragma unroll
        for (int n = 0; n < 2; ++n) { const bf16x8 vf = *(const LAS bf16x8*)(Vt + (16 * (eh * 2 + n) + li) * 136 + ks * 32 + lq * 8); acc[n] = MFMA16(vf, kf, acc[n]); } }
#pragma unroll
    for (int n = 0; n < 2; ++n) *(f32x4*)(KV + (16 * dtile + li) * 64 + 16 * (eh * 2 + n) + lq * 4) = acc[n];
    __syncthreads();
}

__device__ __forceinline__ void retout_unit(LAS unsigned char* lds, const Args& A, int l, int unit, int tid) {
    asm volatile("" : "+v"(tid));
    const int c = unit & 63, h = (unit >> 6) & 3, b = unit >> 8;
    const int lane = tid & 63, w = tid >> 6, li = lane & 15, lq = lane >> 4;
    const bf16* Z = (const bf16*)(A.ws + WS_Z);
    bf16* MIX = (bf16*)(A.ws + WS_MIX);
    const float* KVb = (const float*)(A.ws + WS_KV) + (size_t)((b * 4 + h) * 64) * 4096;
    LAS bf16* Qs = (LAS bf16*)lds;
    LAS bf16* Ks = (LAS bf16*)(lds + 18432);
    LAS bf16* Bt = (LAS bf16*)(lds + 36864);
    LAS bf16* P = (LAS bf16*)(lds + 62464) + w * (16 * 200);
    const size_t rowbase = (size_t)b * SEQ + (size_t)c * 128;
    const float l2g = log2gamma(h);
#pragma unroll
    for (int i = 0; i < 2; ++i) {
        const int ci = tid + 512 * i, j = ci >> 3, p = ci & 7;
        const bf16* zr = Z + (rowbase + j) * INW;
        const u32x4 rq = *(const u32x4*)(zr + ZC_RQ + h * 64 + p * 8), rk = *(const u32x4*)(zr + ZC_RK + h * 64 + p * 8), rv = *(const u32x4*)(zr + ZC_RV + h * 64 + p * 8);
        *(LAS u32x4*)(Qs + j * 72 + p * 8) = rq;
        float fk[8]; UNPACK8(rk, fk);
#pragma unroll
        for (int e = 0; e < 8; ++e) fk[e] *= 0.125f;
        *(LAS u32x4*)(Ks + j * 72 + p * 8) = PACK8(fk);
        float fv[8]; UNPACK8(rv, fv);
#pragma unroll
        for (int e = 0; e < 8; ++e) Bt[(p * 8 + e) * 200 + j] = (bf16)f2bf(fv[e]);
    }
    {
        const float g128 = exp2f(128.f * l2g);
        f32x4 s0 = (f32x4){0.f, 0.f, 0.f, 0.f}, s1 = s0;
        const float* kp = KVb + tid * 8;
        for (int j = 0; j < c; ++j) { const f32x4 a = *(const f32x4*)(kp + (size_t)j * 4096), bq = *(const f32x4*)(kp + (size_t)j * 4096 + 4); s0 = s0 * g128 + a; s1 = s1 * g128 + bq; }
        const int d = tid >> 3, e0 = (tid & 7) * 8;
        Bt[(e0 + 0) * 200 + 128 + d] = (bf16)f2bf(s0.x); Bt[(e0 + 1) * 200 + 128 + d] = (bf16)f2bf(s0.y); Bt[(e0 + 2) * 200 + 128 + d] = (bf16)f2bf(s0.z); Bt[(e0 + 3) * 200 + 128 + d] = (bf16)f2bf(s0.w);
        Bt[(e0 + 4) * 200 + 128 + d] = (bf16)f2bf(s1.x); Bt[(e0 + 5) * 200 + 128 + d] = (bf16)f2bf(s1.y); Bt[(e0 + 6) * 200 + 128 + d] = (bf16)f2bf(s1.z); Bt[(e0 + 7) * 200 + 128 + d] = (bf16)f2bf(s1.w);
        if (c == 63) {
            const f32x4 a = *(const f32x4*)(kp + (size_t)63 * 4096), bq = *(const f32x4*)(kp + (size_t)63 * 4096 + 4);
            float* rp = A.out + O_RETP + (size_t)((l * 2 + b) * 4 + h) * 4096 + tid * 8;
            *(f32x4*)rp = s0 * g128 + a; *(f32x4*)(rp + 4) = s1 * g128 + bq;
        }
    }
    __syncthreads();
    {
        const int i = 16 * w + li; const float qd = exp2f((float)(i + 1) * l2g);
#pragma unroll
        for (int hh = 0; hh < 2; ++hh) { const u32x4 rq = *(const LAS u32x4*)(Qs + i * 72 + lq * 16 + hh * 8); float f[8]; UNPACK8(rq, f);
#pragma unroll
            for (int e = 0; e < 8; ++e) f[e] *= qd;
            *(LAS u32x4*)(P + li * 200 + 128 + lq * 16 + hh * 8) = PACK8(f); }
    }
    bf16x8 qf[2];
#pragma unroll
    for (int kk = 0; kk < 2; ++kk) qf[kk] = *(const LAS bf16x8*)(Qs + (16 * w + li) * 72 + kk * 32 + lq * 8);
#pragma unroll
    for (int nt = 0; nt < 8; ++nt) {
        u32x2 pk = (u32x2){0u, 0u};
        if (nt <= w) {
            f32x4 acc = (f32x4){0.f, 0.f, 0.f, 0.f};
#pragma unroll
            for (int kk = 0; kk < 2; ++kk) { const bf16x8 kf = *(const LAS bf16x8*)(Ks + (16 * nt + li) * 72 + kk * 32 + lq * 8); acc = MFMA16(kf, qf[kk], acc); }
            float v[4];
#pragma unroll
            for (int r = 0; r < 4; ++r) { const int diff = 16 * w + li - 16 * nt - lq * 4 - r; v[r] = diff >= 0 ? acc[r] * exp2f((float)diff * l2g) : 0.f; }
            pk.x = pk2(v[0], v[1]); pk.y = pk2(v[2], v[3]);
        }
        *(LAS u32x2*)(P + li * 200 + 16 * nt + lq * 4) = pk;
    }
    LDS_WAIT();
    f32x4 o[4];
#pragma unroll
    for (int dt = 0; dt < 4; ++dt) o[dt] = (f32x4){0.f, 0.f, 0.f, 0.f};
#pragma unroll
    for (int ks = 0; ks < 6; ++ks) { const bf16x8 pf = *(const LAS bf16x8*)(P + li * 200 + ks * 32 + lq * 8);
#pragma unroll
        for (int dt = 0; dt < 4; ++dt) { const bf16x8 bf = *(const LAS bf16x8*)(Bt + (16 * dt + li) * 200 + ks * 32 + lq * 8); o[dt] = MFMA16(bf, pf, o[dt]); } }
    float sm = 0.f;
#pragma unroll
    for (int dt = 0; dt < 4; ++dt) sm += (o[dt][0] + o[dt][1]) + (o[dt][2] + o[dt][3]);
    sm += __shfl_xor(sm, 16); sm += __shfl_xor(sm, 32);
    const float mean = sm * (1.f / 64.f);
    float q = 0.f;
#pragma unroll
    for (int dt = 0; dt < 4; ++dt) { o[dt] = o[dt] - mean; q += (o[dt][0] * o[dt][0] + o[dt][1] * o[dt][1]) + (o[dt][2] * o[dt][2] + o[dt][3] * o[dt][3]); }
    q += __shfl_xor(q, 16); q += __shfl_xor(q, 32);
    const float rstd = rsqrtf(q * (1.f / 64.f) + EPS);
    const size_t row = rowbase + 16 * w + li;
#pragma unroll
    for (int dt = 0; dt < 4; ++dt) {
        const u32x2 rg = *(const u32x2*)(Z + row * INW + ZC_RG + h * 64 + 16 * dt + lq * 4);
        const float g0 = bflo(rg.x), g1 = bfhi(rg.x), g2 = bflo(rg.y), g3 = bfhi(rg.y);
        u32x2 pk; pk.x = pk2(o[dt][0] * rstd * g0 * sigmoidf_(g0), o[dt][1] * rstd * g1 * sigmoidf_(g1)); pk.y = pk2(o[dt][2] * rstd * g2 * sigmoidf_(g2), o[dt][3] * rstd * g3 * sigmoidf_(g3));
        *(u32x2*)(MIX + row * D + h * 64 + 16 * dt + lq * 4) = pk;
    }
    __syncthreads();
}

__device__ __forceinline__ void conf_unit(LAS unsigned char* lds, const Args& A, int l, int unit, int tid) {
    asm volatile("" : "+v"(tid));
    const int tile = unit & 255, b = unit >> 8, t0 = tile * 32;
    const int lane = tid & 63, w = tid >> 6;
    const bf16* Z = (const bf16*)(A.ws + WS_Z);
    bf16* MIX = (bf16*)(A.ws + WS_MIX);
    LAS float* U = (LAS float*)lds;
    LAS float* Y = (LAS float*)(lds + 62 * 256 * 4);
    for (int idx = tid; idx < 62 * 32; idx += NTHR) {
        const int rr = idx >> 5, p = idx & 31, t = t0 - 30 + rr;
        float u[8];
#pragma unroll
        for (int e = 0; e < 8; ++e) u[e] = 0.f;
        if (t >= 0) {
            const bf16* zr = Z + ((size_t)b * SEQ + t) * INW;
            const u32x4 ra = *(const u32x4*)(zr + ZC_CA + p * 8), rb = *(const u32x4*)(zr + ZC_CB + p * 8);
            float fa[8], fb[8]; UNPACK8(ra, fa); UNPACK8(rb, fb);
#pragma unroll
            for (int e = 0; e < 8; ++e) u[e] = fa[e] * sigmoidf_(fb[e]);
        }
        *(LAS f32x4*)(U + rr * 256 + p * 8) = (f32x4){u[0], u[1], u[2], u[3]}; *(LAS f32x4*)(U + rr * 256 + p * 8 + 4) = (f32x4){u[4], u[5], u[6], u[7]};
        if (rr >= 30 && t >= SEQ - 30) { float* cp = A.out + O_CONFP + ((size_t)(l * 2 + b) * 30 + (t - (SEQ - 30))) * 256 + p * 8;
            *(f32x4*)cp = (f32x4){u[0], u[1], u[2], u[3]}; *(f32x4*)(cp + 4) = (f32x4){u[4], u[5], u[6], u[7]}; }
    }
    __syncthreads();
    {
        const int ch = tid & 255, half = tid >> 8;
        float wv[31];
#pragma unroll
        for (int j = 0; j < 31; ++j) wv[j] = A.in[I_CDW][(size_t)(l * 31 + j) * 256 + ch];
#pragma unroll
        for (int g = 0; g < 2; ++g) {
            const int base = half * 16 + g * 8;
            float uu[38];
#pragma unroll
            for (int k = 0; k < 38; ++k) uu[k] = U[(base + k) * 256 + ch];
#pragma unroll
            for (int o = 0; o < 8; ++o) { float acc = 0.f;
#pragma unroll
                for (int j = 0; j < 31; ++j) acc += wv[j] * uu[o + j];
                Y[(base + o) * 256 + ch] = acc; }
        }
    }
    __syncthreads();
    const f32x4 lg = *(const f32x4*)(A.in[I_CLG] + l * 256 + lane * 4), lb = *(const f32x4*)(A.in[I_CLB] + l * 256 + lane * 4);
#pragma unroll
    for (int tt = 0; tt < 4; ++tt) {
        const int tok = 4 * w + tt;
        f32x4 y = *(const LAS f32x4*)(Y + tok * 256 + lane * 4);
        const float mean = wave_sum((y.x + y.y) + (y.z + y.w)) * (1.f / 256.f);
        y = y - mean;
        const float rstd = rsqrtf(wave_sum((y.x * y.x + y.y * y.y) + (y.z * y.z + y.w * y.w)) * (1.f / 256.f) + EPS);
        const f32x4 v = y * rstd * lg + lb;
        u32x2 pk; pk.x = pk2(v.x * sigmoidf_(v.x), v.y * sigmoidf_(v.y)); pk.y = pk2(v.z * sigmoidf_(v.z), v.w * sigmoidf_(v.w));
        *(u32x2*)(MIX + ((size_t)b * SEQ + t0 + tok) * D + 512 + lane * 4) = pk;
    }
    __syncthreads();
}

__device__ __forceinline__ void sconv_unit(const Args& A, int l, int unit, int tid) {
    asm volatile("" : "+v"(tid));
    const int tile = unit & 127, b = unit >> 7;
    const bf16* Z = (const bf16*)(A.ws + WS_Z);
    bf16* MIX = (bf16*)(A.ws + WS_MIX);
    const int ch0 = (tid & 31) * 8;
    float w0[8], w1[8], w2[8];
#pragma unroll
    for (int e = 0; e < 8; ++e) { w0[e] = A.in[I_SDW][(l * 3 + 0) * 256 + ch0 + e]; w1[e] = A.in[I_SDW][(l * 3 + 1) * 256 + ch0 + e]; w2[e] = A.in[I_SDW][(l * 3 + 2) * 256 + ch0 + e]; }
#pragma unroll
    for (int i = 0; i < 4; ++i) {
        const int t = tile * 64 + (tid >> 5) + 16 * i;
        const size_t row = (size_t)b * SEQ + t;
        float g[3][8];
#pragma unroll
        for (int k = 0; k < 3; ++k) {
#pragma unroll
            for (int e = 0; e < 8; ++e) g[k][e] = 0.f;
            if (t - k >= 0) { const bf16* zr = Z + (row - k) * INW; const u32x4 rc = *(const u32x4*)(zr + ZC_SC + ch0), rh = *(const u32x4*)(zr + ZC_SH + ch0);
                float fc[8], fh[8]; UNPACK8(rc, fc); UNPACK8(rh, fh);
#pragma unroll
                for (int e = 0; e < 8; ++e) g[k][e] = fc[e] * fh[e]; }
        }
        const u32x4 rb = *(const u32x4*)(Z + row * INW + ZC_SB + ch0);
        float fb[8], o[8]; UNPACK8(rb, fb);
#pragma unroll
        for (int e = 0; e < 8; ++e) o[e] = fb[e] * (w0[e] * g[2][e] + w1[e] * g[1][e] + w2[e] * g[0][e]);
        *(u32x4*)(MIX + row * D + 768 + ch0) = PACK8(o);
        if (t >= SEQ - 2) { float* sp = A.out + O_SCP + ((size_t)(l * 2 + b) * 2 + (t - (SEQ - 2))) * 256 + ch0;
            *(f32x4*)sp = (f32x4){g[0][0], g[0][1], g[0][2], g[0][3]}; *(f32x4*)(sp + 4) = (f32x4){g[0][4], g[0][5], g[0][6], g[0][7]}; }
    }
}

__device__ __forceinline__ void sample_unit(LAS unsigned char* lds, const Args& A, int l, int b, int tid) {
    asm volatile("" : "+v"(tid));
    const int lane = tid & 63, w = tid >> 6;
    const bf16* Z = (const bf16*)(A.ws + WS_Z);
    bf16* MIX = (bf16*)(A.ws + WS_MIX);
    LAS float* Zs = (LAS float*)lds;
    LAS float* KD = (LAS float*)(lds + 90112);
    LAS float* Qn = (LAS float*)(lds + 98304);
    LAS float* Kn = (LAS float*)(lds + 106496);
    LAS float* Sc = (LAS float*)(lds + 110592);
    LAS float* Y = Sc;
    LAS float* PART = (LAS float*)(lds + 128000);
    LAS float* ATT = (LAS float*)(lds + 144384);
    const size_t row0 = (size_t)TP + (size_t)b * 8;
    const size_t lb = (size_t)l * 128 + b;
    for (int idx = tid; idx < 8 * 352; idx += NTHR) { const int r = idx / 352, p = idx % 352;
        const u32x4 raw = *(const u32x4*)(Z + (row0 + r) * INW + p * 8); float f[8]; UNPACK8(raw, f);
        *(LAS f32x4*)(Zs + r * INW + p * 8) = (f32x4){f[0], f[1], f[2], f[3]}; *(LAS f32x4*)(Zs + r * INW + p * 8 + 4) = (f32x4){f[4], f[5], f[6], f[7]}; }
    __syncthreads();
    if (tid < 256) {
        const int ch = tid;
        float xp[10];
        xp[0] = A.in[I_SSC][(lb * 2 + 0) * 256 + ch]; xp[1] = A.in[I_SSC][(lb * 2 + 1) * 256 + ch];
#pragma unroll
        for (int t = 0; t < 8; ++t) xp[2 + t] = Zs[t * INW + ZC_SC + ch] * Zs[t * INW + ZC_SH + ch];
        const float w0 = A.in[I_SDW][(l * 3 + 0) * 256 + ch], w1 = A.in[I_SDW][(l * 3 + 1) * 256 + ch], w2 = A.in[I_SDW][(l * 3 + 2) * 256 + ch];
#pragma unroll
        for (int t = 0; t < 8; ++t) { const float y = w0 * xp[t] + w1 * xp[t + 1] + w2 * xp[t + 2];
            MIX[(row0 + t) * D + 768 + ch] = (bf16)f2bf(Zs[t * INW + ZC_SB + ch] * y); }
        A.out[O_SCS + (lb * 2 + 0) * 256 + ch] = xp[8]; A.out[O_SCS + (lb * 2 + 1) * 256 + ch] = xp[9];
    } else {
        const int ch = tid - 256;
        float xp[38];
#pragma unroll
        for (int k = 0; k < 30; ++k) xp[k] = A.in[I_SCONF][(lb * 30 + k) * 256 + ch];
#pragma unroll
        for (int t = 0; t < 8; ++t) xp[30 + t] = Zs[t * INW + ZC_CA + ch] * sigmoidf_(Zs[t * INW + ZC_CB + ch]);
        float acc[8];
#pragma unroll
        for (int t = 0; t < 8; ++t) acc[t] = 0.f;
#pragma unroll
        for (int j = 0; j < 31; ++j) { const float wj = A.in[I_CDW][(size_t)(l * 31 + j) * 256 + ch];
#pragma unroll
            for (int t = 0; t < 8; ++t) acc[t] += wj * xp[t + j]; }
#pragma unroll
        for (int t = 0; t < 8; ++t) Y[t * 256 + ch] = acc[t];
#pragma unroll
        for (int i = 0; i < 30; ++i) A.out[O_CONFS + (lb * 30 + i) * 256 + ch] = xp[8 + i];
    }
#pragma unroll
    for (int i = 0; i < 6; ++i) {
        const int v = w * 6 + i;
        if (v < 32) { const int t = v >> 2, h = v & 3; const float x = Zs[t * INW + ZC_AQ + h * 64 + lane];
            const float rs = rsqrtf(wave_sum(x * x) * (1.f / 64.f) + EPS) * 0.125f; Qn[t * 256 + h * 64 + lane] = x * rs * A.in[I_QG][l * 64 + lane]; }
        else { const int v2 = v - 32, t = v2 >> 1, kh = v2 & 1; const float x = Zs[t * INW + ZC_AK + kh * 64 + lane];
            const float rs = rsqrtf(wave_sum(x * x) * (1.f / 64.f) + EPS); Kn[t * 128 + kh * 64 + lane] = x * rs * A.in[I_KG][l * 64 + lane]; }
    }
#pragma unroll
    for (int i = 0; i < 4; ++i) { const int idx = tid + 512 * i, j = idx >> 8, c = idx & 255;
        KD[idx] = Zs[j * INW + ZC_RK + c] * 0.125f * exp2f((float)(7 - j) * log2gamma(c >> 6)); }
    if (tid < 256) { const int h = tid >> 6, i = (tid >> 3) & 7, j = tid & 7;
        float dot = 0.f;
        for (int d = 0; d < 64; ++d) dot += Zs[i * INW + ZC_RQ + h * 64 + d] * Zs[j * INW + ZC_RK + h * 64 + d];
        ATT[tid] = (j <= i) ? dot * 0.125f * exp2f((float)(i - j) * log2gamma(h)) : 0.f; }
    __syncthreads();
    {
        const f32x4 lg = *(const f32x4*)(A.in[I_CLG] + l * 256 + lane * 4), lbv = *(const f32x4*)(A.in[I_CLB] + l * 256 + lane * 4);
        f32x4 y = *(const LAS f32x4*)(Y + w * 256 + lane * 4);
        const float mean = wave_sum((y.x + y.y) + (y.z + y.w)) * (1.f / 256.f);
        y = y - mean;
        const float rstd = rsqrtf(wave_sum((y.x * y.x + y.y * y.y) + (y.z * y.z + y.w * y.w)) * (1.f / 256.f) + EPS);
        const f32x4 v = y * rstd * lg + lbv;
        u32x2 pk; pk.x = pk2(v.x * sigmoidf_(v.x), v.y * sigmoidf_(v.y)); pk.y = pk2(v.z * sigmoidf_(v.z), v.w * sigmoidf_(v.w));
        *(u32x2*)(MIX + (row0 + w) * D + 512 + lane * 4) = pk;
    }
    {
        const int h = tid >> 7, e = tid & 63, dh = (tid >> 6) & 1;
        const float l2g = log2gamma(h), cdec = exp2f(8.f * l2g);
        float v[8], accq[8];
#pragma unroll
        for (int j = 0; j < 8; ++j) { v[j] = Zs[j * INW + ZC_RV + h * 64 + e]; accq[j] = 0.f; }
        const float* sp = A.in[I_SRET] + ((lb * 4 + h) * 64 + dh * 32) * 64 + e;
        float* op = A.out + O_RETS + ((lb * 4 + h) * 64 + dh * 32) * 64 + e;
#pragma unroll 8
        for (int dd = 0; dd < 32; ++dd) {
            const int d = dh * 32 + dd;
            const float s = sp[dd * 64];
            float sn = s * cdec;
#pragma unroll
            for (int t = 0; t < 8; ++t) { accq[t] += Zs[t * INW + ZC_RQ + h * 64 + d] * s; sn += KD[t * 256 + h * 64 + d] * v[t]; }
            op[dd * 64] = sn;
        }
#pragma unroll
        for (int t = 0; t < 8; ++t) PART[((h * 2 + dh) * 8 + t) * 64 + e] = accq[t];
    }
    __syncthreads();
    {
        const int h = tid >> 7, e = tid & 63, tg = (tid >> 6) & 1;
        const float l2g = log2gamma(h);
#pragma unroll
        for (int tt = 0; tt < 4; ++tt) {
            const int t = tg * 4 + tt;
            float o = exp2f((float)(t + 1) * l2g) * (PART[((h * 2) * 8 + t) * 64 + e] + PART[((h * 2 + 1) * 8 + t) * 64 + e]);
#pragma unroll
            for (int j = 0; j < 8; ++j) o += ATT[h * 64 + t * 8 + j] * Zs[j * INW + ZC_RV + h * 64 + e];
            const float mean = wave_sum(o) * (1.f / 64.f);
            o -= mean;
            const float rstd = rsqrtf(wave_sum(o * o) * (1.f / 64.f) + EPS);
            const float g = Zs[t * INW + ZC_RG + h * 64 + e];
            MIX[(row0 + t) * D + h * 64 + e] = (bf16)f2bf(o * rstd * g * sigmoidf_(g));
        }
    }
    {
        const int kvh = tid >> 8, j = tid & 255;
        if (j < 136) {
            float key[64];
            if (j < 128) { const float* kp = A.in[I_CK] + ((lb * 128 + j) * 2 + kvh) * 64;
#pragma unroll
                for (int d4 = 0; d4 < 16; ++d4) { const f32x4 kv = *(const f32x4*)(kp + d4 * 4); key[d4 * 4] = kv.x; key[d4 * 4 + 1] = kv.y; key[d4 * 4 + 2] = kv.z; key[d4 * 4 + 3] = kv.w; } }
            else {
#pragma unroll
                for (int d4 = 0; d4 < 16; ++d4) { const f32x4 kv = *(const LAS f32x4*)(Kn + (j - 128) * 128 + kvh * 64 + d4 * 4); key[d4 * 4] = kv.x; key[d4 * 4 + 1] = kv.y; key[d4 * 4 + 2] = kv.z; key[d4 * 4 + 3] = kv.w; } }
#pragma unroll 1
            for (int gt = 0; gt < 16; ++gt) {
                const int g = gt >> 3, t = gt & 7, head = kvh * 2 + g;
                float dot = 0.f;
#pragma unroll
                for (int d4 = 0; d4 < 16; ++d4) { const f32x4 q = *(const LAS f32x4*)(Qn + t * 256 + head * 64 + d4 * 4);
                    dot += q.x * key[d4 * 4] + q.y * key[d4 * 4 + 1] + q.z * key[d4 * 4 + 2] + q.w * key[d4 * 4 + 3]; }
                const int dist = t + 128 - j;
                const float slope = exp2f(-2.f * (float)(head + 1));
                Sc[(kvh * 16 + gt) * 136 + j] = (dist >= 0 && dist <= 128) ? dot - slope * (float)dist : -INFINITY;
            }
        }
#pragma unroll
        for (int k = 0; k < 8; ++k) { const int idx4 = tid + 512 * k, i = idx4 >> 5, c4 = (idx4 & 31) * 4;
            f32x4 kk, vv;
            if (i < 120) { kk = *(const f32x4*)(A.in[I_CK] + (lb * 128 + i + 8) * 128 + c4); vv = *(const f32x4*)(A.in[I_CV] + (lb * 128 + i + 8) * 128 + c4); }
            else { kk = *(const LAS f32x4*)(Kn + (i - 120) * 128 + c4); vv = *(const LAS f32x4*)(Zs + (i - 120) * INW + ZC_AV + c4); }
            *(f32x4*)(A.out + O_KS + (lb * 128 + i) * 128 + c4) = kk; *(f32x4*)(A.out + O_VS + (lb * 128 + i) * 128 + c4) = vv; }
    }
    __syncthreads();
#pragma unroll
    for (int rr = 0; rr < 4; ++rr) {
        const int row = 4 * w + rr, head = (row >> 4) * 2 + ((row >> 3) & 1);
        const float sink = A.in[I_SINK][l * 4 + head];
        const float v0 = Sc[row * 136 + lane], v1 = Sc[row * 136 + 64 + lane], v2 = (lane < 8) ? Sc[row * 136 + 128 + lane] : -INFINITY;
        const float mx = fmaxf(wave_max(fmaxf(fmaxf(v0, v1), v2)), sink);
        const float p0 = __expf(v0 - mx), p1 = __expf(v1 - mx), p2 = __expf(v2 - mx);
        const float inv = 1.f / (wave_sum(p0 + p1 + p2) + __expf(sink - mx));
        Sc[row * 136 + lane] = p0 * inv; Sc[row * 136 + 64 + lane] = p1 * inv; if (lane < 8) Sc[row * 136 + 128 + lane] = p2 * inv;
    }
    __syncthreads();
    {
        const int kvh = tid >> 8, d = tid & 63, rg = (tid >> 6) & 3;
        float acc[4] = {0.f, 0.f, 0.f, 0.f};
        const float* vp = A.in[I_CV] + (lb * 128 * 2 + kvh) * 64 + d;
#pragma unroll 8
        for (int j = 0; j < 128; ++j) { const float v = vp[(size_t)j * 128];
#pragma unroll
            for (int rr = 0; rr < 4; ++rr) acc[rr] += Sc[(kvh * 16 + rg * 4 + rr) * 136 + j] * v; }
#pragma unroll
        for (int j = 0; j < 8; ++j) { const float v = Zs[j * INW + ZC_AV + kvh * 64 + d];
#pragma unroll
            for (int rr = 0; rr < 4; ++rr) acc[rr] += Sc[(kvh * 16 + rg * 4 + rr) * 136 + 128 + j] * v; }
#pragma unroll
        for (int rr = 0; rr < 4; ++rr) { const int r16 = rg * 4 + rr, g = r16 >> 3, t = r16 & 7;
            MIX[(row0 + t) * D + 256 + (kvh * 2 + g) * 64 + d] = (bf16)f2bf(acc[rr]); }
    }
    __syncthreads();
}

__global__ void __launch_bounds__(NTHR) fwd_megakernel(Args A) {
    extern __shared__ __attribute__((aligned(16))) unsigned char lds_raw[];
    LAS unsigned char* lds = (LAS unsigned char*)lds_raw;
    cg::grid_group grid = cg::this_grid();
    const int tid = threadIdx.x;
    const int G = gridDim.x, bx = blockIdx.x;
    bf16* XN = (bf16*)(A.ws + WS_XN); bf16* Zb = (bf16*)(A.ws + WS_Z); bf16* MIX = (bf16*)(A.ws + WS_MIX); bf16* Hb = (bf16*)(A.ws + WS_H);

#ifndef PHMASK
#define PHMASK 0xFFFF
#endif
    if (PHMASK & 1) p0_prologue(lds, A, tid);
    grid.sync();
    for (int l = 0; l < NL; ++l) {
        const float* mod = (const float*)(A.ws + WS_MOD) + (size_t)l * NMODR * MODW;
        if (PHMASK & 2) norm_phase(A, l, 0, tid);
        grid.sync();
        if (PHMASK & 4) {
            pg8::Gemm g{XN, (const bf16*)(A.ws + WS_WIN) + (size_t)l * INW * D, T, INW, D}; pg8::StaticOrder S; S.init(T, INW, G, bx);
            pg8::EpiBf16<0> E{Zb, INW};
            pg8::gemm_phase<pg8::EpiBf16<0>, pg8::StaticOrder, true, true>(lds, g, S, E);
        }
        grid.sync();
        for (int it = bx; it < 1920; it += G) {
            if (it < 128) { if (PHMASK & 8) sample_unit(lds, A, l, it, tid); }
            else if (it < 640) { if (PHMASK & 16) attn_unit(lds, A, l, it - 128, tid); }
            else if (it < 1152) { if (PHMASK & 32) conf_unit(lds, A, l, it - 640, tid); }
            else if (it < 1664) { if (PHMASK & 64) retkv_unit(lds, A, it - 1152, tid); }
            else { if (PHMASK & 128) sconv_unit(A, l, it - 1664, tid); }
        }
        grid.sync();
        if (PHMASK & 256) for (int it = bx; it < 512; it += G) retout_unit(lds, A, l, it, tid);
        grid.sync();
        if (PHMASK & 512) {
            pg8::Gemm g{MIX, (const bf16*)(A.ws + WS_WOUT) + (size_t)l * D * D, T, D, D}; pg8::StaticOrder S; S.init(T, D, G, bx);
            pg8::EpiRes E{l == 0 ? A.in[I_XP] : A.out, l == 0 ? A.in[I_XS] : A.out + (size_t)TP * D, A.out, mod + 2 * D, D, TP, MODW};
            pg8::gemm_phase<pg8::EpiRes, pg8::StaticOrder, true, true>(lds, g, S, E);
        }
        grid.sync();
        if (PHMASK & 2) norm_phase(A, l, 1, tid);
        grid.sync();
        if (PHMASK & 1024) {
            pg8::Gemm g{XN, (const bf16*)(A.ws + WS_W1) + (size_t)l * FF * D, T, FF, D}; pg8::StaticOrder S; S.init(T, FF, G, bx);
            pg8::EpiBf16<2> E{Hb, FF};
            pg8::gemm_phase<pg8::EpiBf16<2>, pg8::StaticOrder, true, true>(lds, g, S, E);
        }
        grid.sync();
        if (PHMASK & 2048) {
            pg8::Gemm g{Hb, (const bf16*)(A.ws + WS_W2) + (size_t)l * D * FF, T, D, FF}; pg8::StaticOrder S; S.init(T, D, G, bx);
            pg8::EpiRes E{A.out, A.out + (size_t)TP * D, A.out, mod + 5 * D, D, TP, MODW};
            pg8::gemm_phase<pg8::EpiRes, pg8::StaticOrder, true, true>(lds, g, S, E);
        }
        if (l + 1 < NL) grid.sync();
    }
}

extern "C" void kernel_launch(void* const* d_in, const int* in_sizes, int n_in, void* d_out, int out_size, void* d_ws, size_t ws_size, hipStream_t stream) {
    static int grid = 0;
    if (grid == 0) {
        if (n_in != 24 || (size_t)out_size != O_END || ws_size < WS_END) { fprintf(stderr, "kernel_launch: unexpected shapes n_in %d out %d ws %zu\n", n_in, out_size, ws_size); grid = -1; return; }
        int dev = 0, cus = 0, per_cu = 0;
        hipGetDevice(&dev); hipDeviceGetAttribute(&cus, hipDeviceAttributeMultiprocessorCount, dev);
        hipFuncSetAttribute((const void*)fwd_megakernel, hipFuncAttributeMaxDynamicSharedMemorySize, LDS_BYTES);
        hipOccupancyMaxActiveBlocksPerMultiprocessor(&per_cu, (const void*)fwd_megakernel, NTHR, LDS_BYTES);
        if (per_cu < 1) { fprintf(stderr, "kernel_launch: occupancy query says %d blocks per CU\n", per_cu); per_cu = 1; }
        grid = cus;
        (void)hipGetLastError();
    }
    if (grid < 0) return;
    Args a{};
    for (int i = 0; i < 24; ++i) a.in[i] = (const float*)d_in[i];
    a.out = (float*)d_out; a.ws = (unsigned char*)d_ws;
    void* args[] = {&a};
    hipError_t e = hipLaunchCooperativeKernel((const void*)fwd_megakernel, dim3(grid), dim3(NTHR), args, LDS_BYTES, stream);
    if (e != hipSuccess) fprintf(stderr, "cooperative launch failed: %s (grid %d)\n", hipGetErrorString(e), grid);
}
```

```cpp
#include <hip/hip_runtime.h>
#include <hip/hip_cooperative_groups.h>
#include <cstdio>
#include <cstdint>
namespace cg = cooperative_groups;
namespace pg8 {
#define PG8_LAS __attribute__((address_space(3)))
typedef unsigned short bf16_t;
typedef short bf16x8 __attribute__((ext_vector_type(8)));
typedef float f32x4 __attribute__((ext_vector_type(4)));
typedef unsigned u32x4 __attribute__((ext_vector_type(4)));
constexpr int BM = 256, BK = 64, HALF = 128, HTB = HALF * BK * 2  , STAGE_BYTES = 8 * HTB, NXCD = 8, WGM = 8;

__host__ __device__ __forceinline__ int lds_byte(int r, int c) { const int st = (r >> 4) * 2 + (c >> 5), rr = r & 15, cc = c & 31, ob = rr * 64 + cc * 2; return st * 1024 + (ob ^ (((ob >> 9) & 1) << 5)); }
__host__ __device__ __forceinline__ void stage_rc(int b, int& R, int& C) { const int st = b / 1024, sb = b % 1024, swz = sb ^ (((sb >> 9) & 1) << 5); R = (st >> 1) * 16 + swz / 64; C = (st & 1) * 32 + (swz % 64) / 2; }
__host__ __device__ __forceinline__ int perm32(int rho) { const int n = rho >> 4, i = rho & 15; return 8 * (i >> 2) + 4 * n + (i & 3); }

struct Unit { int pm, pn; };
struct Gemm { const bf16_t* A; const bf16_t* Bt; int M, N, K; };

struct StaticOrder {
    int nM, nN, nwg, G, c;
    __host__ __device__ void init(int M, int N, int G_, int c_) { nM = M / BM; nN = N / BM; nwg = nM * nN; G = G_; c = c_; }
    __host__ __device__ bool next(int i, Unit& u) const {
        const long L = (long)i * G + c; if (L >= nwg) return false;
        int wgid = (int)L; { const int q = nwg / NXCD, r = nwg % NXCD, xcd = wgid % NXCD, off = wgid / NXCD; wgid = (xcd < r ? xcd * (q + 1) : r * (q + 1) + (xcd - r) * q) + off; }
        const int nig = WGM * nN, gid = wgid / nig, fm = gid * WGM, gsz = (nM - fm) < WGM ? (nM - fm) : WGM;
        u.pm = fm + ((wgid % nig) % gsz); u.pn = (wgid % nig) / gsz; return true;
    }
    __device__ __forceinline__ void a_ready(const Unit&) const {}
    __device__ __forceinline__ void done(const Unit&) const {}
};


__device__ __forceinline__ unsigned cvt_pk_bf16(float lo, float hi) { unsigned r; asm volatile("v_cvt_pk_bf16_f32 %0, %1, %2" : "=v"(r) : "v"(lo), "v"(hi)); return r; }

template <int ACT  > struct EpiBf16 {
    static constexpr bool PERM = true, AFTER_DRAIN = false;
    bf16_t* O; int ldc;
    __device__ __forceinline__ void operator()(const f32x4 (&acc)[2][2][4][2], const Unit& u, int wr, int wc, int fr, int fq) const {
        const int row0 = u.pm * BM + wr * 64 + fr; const int col0 = u.pn * BM + wc * 32 + 8 * fq;
#pragma unroll
        for (int ai = 0; ai < 2; ++ai)
#pragma unroll
            for (int m = 0; m < 4; ++m) { bf16_t* rowp = O + (size_t)(row0 + ai * HALF + m * 16) * ldc + col0;
#pragma unroll
                for (int bj = 0; bj < 2; ++bj) { f32x4 v0 = acc[ai][bj][m][0], v1 = acc[ai][bj][m][1];
                    if (ACT == 2) {
#pragma unroll
                        for (int e = 0; e < 4; ++e) { float a = fmaxf(v0[e], 0.f), b = fmaxf(v1[e], 0.f); v0[e] = a * a; v1[e] = b * b; }
                    }
                    u32x4 w; w.x = cvt_pk_bf16(v0[0], v0[1]); w.y = cvt_pk_bf16(v0[2], v0[3]); w.z = cvt_pk_bf16(v1[0], v1[1]); w.w = cvt_pk_bf16(v1[2], v1[3]);
                    *(u32x4*)(rowp + bj * HALF) = w; } }
    }
};

struct EpiRes {
    static constexpr bool PERM = false, AFTER_DRAIN = false;
    const float* baseP; const float* baseS; float* out; const float* gate; int ldc; int tprows; int gstride;
    __device__ __forceinline__ void operator()(const f32x4 (&acc)[2][2][4][2], const Unit& u, int wr, int wc, int fr, int fq) const {
        const int col0 = u.pn * BM + wc * 32 + 4 * fq;
#pragma unroll
        for (int ai = 0; ai < 2; ++ai)
#pragma unroll
            for (int m = 0; m < 4; ++m) {
                const int row = u.pm * BM + ai * HALF + wr * 64 + m * 16 + fr;
                const int gr = row < tprows ? (row >> 13) : 2 + ((row - tprows) >> 3);
                const float* gp = gate + (size_t)gr * gstride + col0;
                const float* bp = (row < tprows ? baseP + (size_t)row * ldc : baseS + (size_t)(row - tprows) * ldc) + col0;
                float* op = out + (size_t)row * ldc + col0;
#pragma unroll
                for (int bj = 0; bj < 2; ++bj)
#pragma unroll
                    for (int n = 0; n < 2; ++n) { const int c = bj * HALF + n * 16;
                        const f32x4 g = *(const f32x4*)(gp + c); const f32x4 b = *(const f32x4*)(bp + c);
                        *(f32x4*)(op + c) = b + g * acc[ai][bj][m][n]; }
                asm volatile("" ::: "memory");
            }
    }
};
template <class Epi, class Sched, bool ALIGN_EPI = false, bool SP2 = false>
__device__ __forceinline__ void gemm_phase(PG8_LAS unsigned char* lds, const Gemm g, const Sched& S, const Epi& E) {
    int tid_l = threadIdx.x; asm volatile("" : "+v"(tid_l));
    const int tid = tid_l, wid = __builtin_amdgcn_readfirstlane(tid >> 6), lane = tid & 63, wr = wid >> 2, wc = wid & 3, fr = lane & 15, fq = lane >> 4;
    const int K = g.K, nt = K / BK;
    unsigned voffA[2], voffB[2];
#pragma unroll
    for (int i = 0; i < 2; ++i) { int R, C; stage_rc(tid * 16 + i * 8192, R, C); const int Rb = Epi::PERM ? ((R & ~31) + perm32(R & 31)) : R;
        voffA[i] = (unsigned)(R * K + C) * 2u; voffB[i] = (unsigned)(Rb * K + C) * 2u; }
    const size_t kstep = (size_t)(BK * 2);
    const size_t hstep = (size_t)HALF * K * 2;
    const size_t tstep = 2 * hstep;
    const unsigned ldsw = (unsigned)wid * 1024u;
    const int aoff = lds_byte(wr * 64 + fr, fq * 8), boff = lds_byte(wc * 32 + fr, fq * 8);
#define PG8_SA(b, h) (((b) * 2 + (h)) * HTB)
#define PG8_SB(b, h) ((4 + (b) * 2 + (h)) * HTB)
#define PG8_STAGE(bufoff, gbase, voff) do { _Pragma("unroll") for (int _i = 0; _i < 2; ++_i) \
        __builtin_amdgcn_global_load_lds((const unsigned*)((const char*)(gbase) + (voff)[_i]), (PG8_LAS unsigned*)(lds + (bufoff) + ldsw + _i * 8192), 16, 0, 0); } while (0)
#define PG8_LDA(dst, b, h) do { _Pragma("unroll") for (int m = 0; m < 4; ++m) _Pragma("unroll") for (int k = 0; k < 2; ++k) dst[m][k] = *(const PG8_LAS bf16x8*)(lds + PG8_SA(b, h) + aoff + m * 2048 + k * 1024); } while (0)
#define PG8_LDB(dst, b, h) do { _Pragma("unroll") for (int n = 0; n < 2; ++n) _Pragma("unroll") for (int k = 0; k < 2; ++k) dst[n][k] = *(const PG8_LAS bf16x8*)(lds + PG8_SB(b, h) + boff + n * 2048 + k * 1024); } while (0)
#define PG8_MMA(ai, bj, At, Bt) do { __builtin_amdgcn_s_setprio(1); _Pragma("unroll") for (int m = 0; m < 4; ++m) _Pragma("unroll") for (int n = 0; n < 2; ++n) _Pragma("unroll") for (int k = 0; k < 2; ++k) \
        acc[ai][bj][m][n] = __builtin_amdgcn_mfma_f32_16x16x32_bf16(Bt[n][k], At[m][k], acc[ai][bj][m][n], 0, 0, 0); __builtin_amdgcn_s_setprio(0); } while (0)
#define PG8_WAIT_V(n) asm volatile("s_waitcnt vmcnt(" #n ")" ::: "memory")
#define PG8_WAIT_L(n) asm volatile("s_waitcnt lgkmcnt(" #n ")" ::: "memory")
#define PG8_BAR __builtin_amdgcn_s_barrier()
#define PG8_SCHED __builtin_amdgcn_sched_barrier(0)
    Unit cur, nxt; int ui = 0;
    if (!S.next(0, cur)) return;
    f32x4 acc[2][2][4][2];
#pragma unroll
    for (int a = 0; a < 2; ++a)
#pragma unroll
        for (int b = 0; b < 2; ++b)
#pragma unroll
            for (int m = 0; m < 4; ++m)
#pragma unroll
                for (int n = 0; n < 2; ++n) acc[a][b][m][n] = (f32x4){0.f, 0.f, 0.f, 0.f};
    bf16x8 At[4][2], B0[2][2], B1[2][2];
    const char* cA = (const char*)g.A + (size_t)cur.pm * tstep; const char* cB = (const char*)g.Bt + (size_t)cur.pn * tstep;
    S.a_ready(cur);
    if constexpr (SP2) {
        PG8_STAGE(PG8_SB(0, 0), cB, voffB); PG8_STAGE(PG8_SB(0, 1), cB + hstep, voffB); PG8_STAGE(PG8_SA(0, 0), cA, voffA); PG8_STAGE(PG8_SA(0, 1), cA + hstep, voffA);
        if (wr == 1) PG8_BAR;
        PG8_WAIT_V(2); PG8_BAR;
        PG8_STAGE(PG8_SB(1, 0), cB + kstep, voffB); PG8_STAGE(PG8_SA(1, 0), cA + kstep, voffA); PG8_STAGE(PG8_SB(1, 1), cB + hstep + kstep, voffB);
        PG8_WAIT_V(6); PG8_BAR;
    } else {
        PG8_STAGE(PG8_SB(0, 0), cB, voffB); PG8_STAGE(PG8_SA(0, 0), cA, voffA); PG8_STAGE(PG8_SB(0, 1), cB + hstep, voffB); PG8_STAGE(PG8_SA(0, 1), cA + hstep, voffA);
        if (wr == 1) PG8_BAR;
        PG8_WAIT_V(4); PG8_BAR;
        PG8_STAGE(PG8_SB(1, 0), cB + kstep, voffB); PG8_STAGE(PG8_SA(1, 0), cA + kstep, voffA); PG8_STAGE(PG8_SB(1, 1), cB + hstep + kstep, voffB);
        PG8_WAIT_V(6); PG8_BAR;
    }
    for (;;) {
        const bool has_next = S.next(ui + 1, nxt);
        const char* nA = has_next ? (const char*)g.A + (size_t)nxt.pm * tstep : cA; const char* nB = has_next ? (const char*)g.Bt + (size_t)nxt.pn * tstep : cB;
        for (int t = 0; t < nt; t += 2) {
            const bool last = (t == nt - 2);
            const char* a1 = cA + (size_t)(t + 1) * kstep;
            const char* a2 = last ? nA : cA + (size_t)(t + 2) * kstep; const char* b2 = last ? nB : cB + (size_t)(t + 2) * kstep;
            const char* a3 = a2 + kstep; const char* b3 = b2 + kstep;
            if (last && has_next) S.a_ready(nxt);
            if constexpr (SP2) {
            PG8_LDB(B0, 0, 0); PG8_LDB(B1, 0, 1); PG8_SCHED; PG8_LDA(At, 0, 0); PG8_STAGE(PG8_SA(1, 1), a1 + hstep, voffA);
            PG8_WAIT_V(8); PG8_WAIT_L(0); PG8_BAR; PG8_MMA(0, 0, At, B0); PG8_MMA(0, 1, At, B1); PG8_BAR; PG8_SCHED;
            PG8_LDA(At, 0, 1); PG8_STAGE(PG8_SB(0, 0), b2, voffB); PG8_STAGE(PG8_SB(0, 1), b2 + hstep, voffB); PG8_STAGE(PG8_SA(0, 0), a2, voffA);
            PG8_WAIT_V(8); PG8_WAIT_L(0); PG8_BAR; PG8_MMA(1, 0, At, B0); PG8_MMA(1, 1, At, B1); PG8_BAR; PG8_SCHED;
            PG8_LDB(B0, 1, 0); PG8_LDB(B1, 1, 1); PG8_SCHED; PG8_LDA(At, 1, 0); PG8_STAGE(PG8_SA(0, 1), a2 + hstep, voffA);
            PG8_WAIT_V(8); PG8_WAIT_L(0); PG8_BAR; PG8_MMA(0, 0, At, B0); PG8_MMA(0, 1, At, B1); PG8_BAR; PG8_SCHED;
            PG8_LDA(At, 1, 1); PG8_STAGE(PG8_SB(1, 0), b3, voffB); PG8_STAGE(PG8_SB(1, 1), b3 + hstep, voffB); PG8_STAGE(PG8_SA(1, 0), a3, voffA);
            PG8_WAIT_V(8); PG8_WAIT_L(0); PG8_BAR; PG8_MMA(1, 0, At, B0); PG8_MMA(1, 1, At, B1); PG8_BAR; PG8_SCHED;
            } else {
            PG8_LDB(B0, 0, 0); PG8_SCHED; PG8_LDA(At, 0, 0); PG8_STAGE(PG8_SA(1, 1), a1 + hstep, voffA);
            PG8_WAIT_L(8); PG8_BAR; PG8_WAIT_L(0); PG8_MMA(0, 0, At, B0); PG8_BAR; PG8_SCHED;
            PG8_LDB(B1, 0, 1); PG8_STAGE(PG8_SB(0, 0), b2, voffB);
            PG8_BAR; PG8_WAIT_L(0); PG8_MMA(0, 1, At, B1); PG8_BAR;
            PG8_LDA(At, 0, 1); PG8_STAGE(PG8_SA(0, 0), a2, voffA);
            PG8_BAR; PG8_WAIT_L(0); PG8_MMA(1, 0, At, B0); PG8_BAR; PG8_SCHED;
            PG8_STAGE(PG8_SB(0, 1), b2 + hstep, voffB);
            PG8_WAIT_V(6); PG8_BAR; PG8_MMA(1, 1, At, B1); PG8_BAR;
            PG8_LDB(B0, 1, 0); PG8_SCHED; PG8_LDA(At, 1, 0); PG8_STAGE(PG8_SA(0, 1), a2 + hstep, voffA);
            PG8_WAIT_L(8); PG8_BAR; PG8_WAIT_L(0); PG8_MMA(0, 0, At, B0); PG8_BAR; PG8_SCHED;
            PG8_LDB(B1, 1, 1); PG8_STAGE(PG8_SB(1, 0), b3, voffB);
            PG8_BAR; PG8_WAIT_L(0); PG8_MMA(0, 1, At, B1); PG8_BAR;
            PG8_LDA(At, 1, 1); PG8_STAGE(PG8_SA(1, 0), a3, voffA);
            PG8_BAR; PG8_WAIT_L(0); PG8_MMA(1, 0, At, B0); PG8_BAR; PG8_SCHED;
            PG8_STAGE(PG8_SB(1, 1), b3 + hstep, voffB);
            PG8_WAIT_V(6); PG8_BAR; PG8_MMA(1, 1, At, B1); PG8_BAR;
            }
        }
        if constexpr (ALIGN_EPI) { if (wr == 0) PG8_BAR; }
        if constexpr (!Epi::AFTER_DRAIN) { E(acc, cur, wr, wc, fr, fq); S.done(cur); }
        if (!has_next) break;
#pragma unroll
        for (int a = 0; a < 2; ++a)
#pragma unroll
            for (int b = 0; b < 2; ++b)
#pragma unroll
                for (int m = 0; m < 4; ++m)
#pragma unroll
                    for (int n = 0; n < 2; ++n) acc[a][b][m][n] = (f32x4){0.f, 0.f, 0.f, 0.f};
        cur = nxt; cA = nA; cB = nB; ++ui;
        if constexpr (ALIGN_EPI) { if (wr == 1) PG8_BAR; }
    }
    PG8_WAIT_V(0);
    if constexpr (!ALIGN_EPI) { if (wr == 0) PG8_BAR; }
    PG8_BAR;
    if constexpr (Epi::AFTER_DRAIN) { E.fused(acc, cur, wr, wc, fr, fq, lds, wid, lane); S.done(cur); }
#undef PG8_SA
#undef PG8_SB
#undef PG8_STAGE
#undef PG8_LDA
#undef PG8_LDB
#undef PG8_MMA
#undef PG8_WAIT_V
#undef PG8_WAIT_L
#undef PG8_BAR
#undef PG8_SCHED
}
}

#define LAS __attribute__((address_space(3)))
typedef unsigned short bf16;
typedef short bf16x8 __attribute__((ext_vector_type(8)));
typedef float f32x4 __attribute__((ext_vector_type(4)));
typedef unsigned u32x4 __attribute__((ext_vector_type(4)));
typedef unsigned u32x2 __attribute__((ext_vector_type(2)));

constexpr int NTHR = 512;
constexpr int D = 1024, SEQ = 8192, TP = 16384, TS = 1024, T = TP + TS, INW = 2816, FF = 4096, NL = 2;
constexpr int MODW = 6 * D, NMODR = 130;
constexpr float EPS = 1e-6f;
constexpr int ZC_RQ = 0, ZC_RK = 256, ZC_RV = 512, ZC_RG = 768, ZC_AQ = 1024, ZC_AK = 1280, ZC_AV = 1408, ZC_CA = 1536, ZC_CB = 1792, ZC_SB = 2048, ZC_SC = 2304, ZC_SH = 2560;
constexpr size_t O_YP = 0, O_YS = (size_t)TP * D, O_RETP = O_YS + (size_t)TS * D, O_KP = O_RETP + 2 * 2 * 4 * 4096, O_VP = O_KP + 2 * 2 * 128 * 128,
                 O_CONFP = O_VP + 2 * 2 * 128 * 128, O_SCP = O_CONFP + 2 * 2 * 30 * 256, O_RETS = O_SCP + 2 * 2 * 2 * 256, O_KS = O_RETS + (size_t)2 * 128 * 4 * 4096,
                 O_VS = O_KS + (size_t)2 * 128 * 128 * 128, O_CONFS = O_VS + (size_t)2 * 128 * 128 * 128, O_SCS = O_CONFS + (size_t)2 * 128 * 30 * 256, O_END = O_SCS + (size_t)2 * 128 * 2 * 256;
static_assert(O_END == 32735232, "output size");
constexpr size_t MiB = 1u << 20;
constexpr size_t WS_WIN = 0, WS_WOUT = 12 * MiB, WS_W1 = 16 * MiB, WS_W2 = 32 * MiB, WS_MOD = 48 * MiB, WS_XN = 56 * MiB, WS_H = 90 * MiB,
                 WS_Z = 90 * MiB, WS_MIX = 184 * MiB, WS_KV = 218 * MiB, WS_CTL = 226 * MiB, WS_END = 227 * MiB;
constexpr size_t CTL_BYTES = 16384;
static_assert((size_t)NL * INW * D * 2 <= WS_WOUT && (size_t)NL * NMODR * MODW * 4 <= 8 * MiB && WS_XN + (size_t)T * D * 2 <= WS_H && WS_Z + (size_t)T * INW * 2 <= WS_MIX &&
              WS_MIX + (size_t)T * D * 2 <= WS_KV && WS_KV + (size_t)2 * 4 * 64 * 4096 * 4 <= WS_CTL && WS_H + (size_t)T * FF * 2 <= WS_CTL, "ws map");
constexpr int LDS_BYTES = 147456;

struct Args { const float* in[24]; float* out; unsigned char* ws; };
enum { I_XP = 0, I_XS, I_CP, I_CS, I_SRET, I_CK, I_CV, I_SCONF, I_SSC, I_ADAW, I_ADAB, I_N1G, I_N2G, I_WIN, I_QG, I_KG, I_SINK, I_CDW, I_CLG, I_CLB, I_SDW, I_WOUT, I_WFF1, I_WFF2 };

__device__ __forceinline__ unsigned f2bf(float f) { unsigned u = __builtin_bit_cast(unsigned, f); return (u + 0x7fffu + ((u >> 16) & 1u)) >> 16; }
__device__ __forceinline__ unsigned pk2(float lo, float hi) { return f2bf(lo) | (f2bf(hi) << 16); }
__device__ __forceinline__ float bflo(unsigned u) { return __builtin_bit_cast(float, u << 16); }
__device__ __forceinline__ float bfhi(unsigned u) { return __builtin_bit_cast(float, u & 0xffff0000u); }
#define UNPACK8(raw, f) do { f[0] = bflo(raw.x); f[1] = bfhi(raw.x); f[2] = bflo(raw.y); f[3] = bfhi(raw.y); f[4] = bflo(raw.z); f[5] = bfhi(raw.z); f[6] = bflo(raw.w); f[7] = bfhi(raw.w); } while (0)
#define PACK8(f) ((u32x4){pk2(f[0], f[1]), pk2(f[2], f[3]), pk2(f[4], f[5]), pk2(f[6], f[7])})
#define LDS_WAIT() asm volatile("s_waitcnt lgkmcnt(0)" ::: "memory")
#define MFMA16(a, b, c) __builtin_amdgcn_mfma_f32_16x16x32_bf16((a), (b), (c), 0, 0, 0)
__device__ __forceinline__ float wave_sum(float v) {
#pragma unroll
    for (int o = 1; o < 64; o <<= 1) v += __shfl_xor(v, o);
    return v;
}
__device__ __forceinline__ float wave_max(float v) {
#pragma unroll
    for (int o = 1; o < 64; o <<= 1) v = fmaxf(v, __shfl_xor(v, o));
    return v;
}
__device__ __forceinline__ float sigmoidf_(float x) { return 1.f / (1.f + __expf(-x)); }
__device__ __forceinline__ float log2gamma(int h) { return log2f(1.f - exp2f(-5.f - (float)h)); }

__device__ __forceinline__ void p0_transpose_item(const float* W, int K, int N, bf16* WT, LAS float* scr, int item, int lane) {
    const int nblk = N / 32, kb = item / nblk, nb = item % nblk, k0 = 64 * kb, n0 = 32 * nb;
#pragma unroll 8
    for (int i = 0; i < 32; ++i) { const int kk = 2 * i + (lane >> 5); scr[kk * 33 + (lane & 31)] = W[(size_t)(k0 + kk) * N + n0 + (lane & 31)]; }
    LDS_WAIT();
    const int c = lane & 7;
#pragma unroll
    for (int j = 0; j < 4; ++j) { const int n = (lane >> 3) + 8 * j; const LAS float* s = scr + (8 * c) * 33 + n;
        u32x4 o; o.x = pk2(s[0 * 33], s[1 * 33]); o.y = pk2(s[2 * 33], s[3 * 33]); o.z = pk2(s[4 * 33], s[5 * 33]); o.w = pk2(s[6 * 33], s[7 * 33]);
        *(u32x4*)(WT + (size_t)(n0 + n) * K + k0 + 8 * c) = o; }
    LDS_WAIT();
}

__device__ __forceinline__ void p0_mod_item(LAS unsigned char* lds, const Args& A, int item, int tid) {
    asm volatile("" : "+v"(tid));
    const int l = item / 96, cb = item % 96, col0 = cb * 64;
    const int lane = tid & 63, w = tid >> 6, li = lane & 15, lq = lane >> 4;
    LAS bf16* Wt = (LAS bf16*)lds;
    LAS bf16* SC = (LAS bf16*)(lds + 64 * 264 * 2);
    const float* aw = A.in[I_ADAW] + (size_t)l * D * MODW;
    const int ct = w & 3, rg = w >> 2;
    f32x4 acc[5];
#pragma unroll
    for (int i = 0; i < 5; ++i) acc[i] = (f32x4){0.f, 0.f, 0.f, 0.f};
    for (int kc = 0; kc < 4; ++kc) {
        const int k0 = kc * 256;
        for (int i = 0; i < 32; ++i) { const int kk = (tid >> 6) + 8 * i, c = tid & 63;
            Wt[c * 264 + kk] = (bf16)f2bf(aw[(size_t)(k0 + kk) * MODW + col0 + c]); }
        for (int i = 0; i < 72; ++i) { const int idx = tid + 512 * i, r = idx >> 8, kk = idx & 255;
            float v = 0.f;
            if (r < NMODR) { const float c = (r < 2) ? A.in[I_CP][r * D + k0 + kk] : A.in[I_CS][(size_t)(r - 2) * D + k0 + kk]; v = c * sigmoidf_(c); }
            SC[r * 264 + kk] = (bf16)f2bf(v); }
        __syncthreads();
#pragma unroll
        for (int ks = 0; ks < 8; ++ks) {
            const bf16x8 wf = *(const LAS bf16x8*)(Wt + (ct * 16 + li) * 264 + ks * 32 + lq * 8);
#pragma unroll
            for (int mi = 0; mi < 5; ++mi) { const int mt = rg * 5 + mi;
                if (mt < 9) { const bf16x8 sf = *(const LAS bf16x8*)(SC + (mt * 16 + li) * 264 + ks * 32 + lq * 8); acc[mi] = MFMA16(wf, sf, acc[mi]); } }
        }
        __syncthreads();
    }
    float* mod = (float*)(A.ws + WS_MOD) + (size_t)l * NMODR * MODW;
    const int col = col0 + ct * 16 + lq * 4;
    const f32x4 bias = *(const f32x4*)(A.in[I_ADAB] + (size_t)l * MODW + col);
#pragma unroll
    for (int mi = 0; mi < 5; ++mi) { const int r = (rg * 5 + mi) * 16 + li;
        if (rg * 5 + mi < 9 && r < NMODR) *(f32x4*)(mod + (size_t)r * MODW + col) = acc[mi] + bias; }
}

__device__ __forceinline__ void p0_prologue(LAS unsigned char* lds, const Args& A, int tid) {
    asm volatile("" : "+v"(tid));
    const int G = gridDim.x, bx = blockIdx.x;
    for (int it = bx; it < 192; it += G) p0_mod_item(lds, A, it, tid);
    __syncthreads();
    const int lane = tid & 63, wave = tid >> 6;
    LAS float* scr = (LAS float*)(lds + wave * 16384);
    const int gw = bx * 8 + wave, NGW = G * 8;
    constexpr int I_IN = (D / 64) * (INW / 32), I_O = (D / 64) * (D / 32), I_1 = (D / 64) * (FF / 32), I_2 = (FF / 64) * (D / 32);
    constexpr int PER_L = I_IN + I_O + I_1 + I_2;
    for (int it = gw; it < NL * PER_L; it += NGW) {
        const int l = it / PER_L; int r = it % PER_L;
        if (r < I_IN) { p0_transpose_item(A.in[I_WIN] + (size_t)l * D * INW, D, INW, (bf16*)(A.ws + WS_WIN) + (size_t)l * INW * D, scr, r, lane); continue; } r -= I_IN;
        if (r < I_O) { p0_transpose_item(A.in[I_WOUT] + (size_t)l * D * D, D, D, (bf16*)(A.ws + WS_WOUT) + (size_t)l * D * D, scr, r, lane); continue; } r -= I_O;
        if (r < I_1) { p0_transpose_item(A.in[I_WFF1] + (size_t)l * D * FF, D, FF, (bf16*)(A.ws + WS_W1) + (size_t)l * FF * D, scr, r, lane); continue; } r -= I_1;
        p0_transpose_item(A.in[I_WFF2] + (size_t)l * FF * D, FF, D, (bf16*)(A.ws + WS_W2) + (size_t)l * D * FF, scr, r, lane);
    }
}

__device__ __forceinline__ void norm_phase(const Args& A, int l, int which  , int tid) {
    asm volatile("" : "+v"(tid));
    const int lane = tid & 63, wave = tid >> 6;
    const int gw = blockIdx.x * 8 + wave, NGW = gridDim.x * 8;
    const float* gptr = A.in[which ? I_N2G : I_N1G] + (size_t)l * D;
    const float* mod = (const float*)(A.ws + WS_MOD) + (size_t)l * NMODR * MODW + (which ? 3 * D : 0);
    bf16* XN = (bf16*)(A.ws + WS_XN);
    for (int m = gw; m < T; m += NGW) {
        const float* xr; int r;
        if (m < TP) { r = m >> 13; xr = (l == 0 && which == 0) ? A.in[I_XP] + (size_t)m * D : A.out + (size_t)m * D; }
        else { r = 2 + ((m - TP) >> 3); xr = (l == 0 && which == 0) ? A.in[I_XS] + (size_t)(m - TP) * D : A.out + (size_t)m * D; }
        const float* mr = mod + (size_t)r * MODW;
        f32x4 v[4]; float s = 0.f;
#pragma unroll
        for (int j = 0; j < 4; ++j) { v[j] = *(const f32x4*)(xr + 4 * lane + 256 * j); s += (v[j].x * v[j].x + v[j].y * v[j].y) + (v[j].z * v[j].z + v[j].w * v[j].w); }
        const float rstd = rsqrtf(wave_sum(s) * (1.f / D) + EPS);
#pragma unroll
        for (int j = 0; j < 4; ++j) {
            const f32x4 sh = *(const f32x4*)(mr + 4 * lane + 256 * j), sc = *(const f32x4*)(mr + D + 4 * lane + 256 * j);
            const f32x4 gj = *(const f32x4*)(gptr + 4 * lane + 256 * j);
            const f32x4 o = v[j] * rstd * gj * (sc + 1.f) + sh;
            u32x2 pk; pk.x = pk2(o.x, o.y); pk.y = pk2(o.z, o.w);
            *(u32x2*)(XN + (size_t)m * D + 4 * lane + 256 * j) = pk;
        }
    }
}

__device__ __forceinline__ void attn_unit(LAS unsigned char* lds, const Args& A, int l, int unit, int tid) {
    asm volatile("" : "+v"(tid));
    const int qh = unit & 3, nb = (unit >> 2) & 63, b = unit >> 8, kvh = qh >> 1;
    const int lane = tid & 63, w = tid >> 6, li = lane & 15, lq = lane >> 4;
    const bf16* Z = (const bf16*)(A.ws + WS_Z);
    bf16* MIX = (bf16*)(A.ws + WS_MIX);
    LAS bf16* Qs = (LAS bf16*)lds;
    LAS bf16* Ks = (LAS bf16*)(lds + 18432);
    LAS bf16* Vt = (LAS bf16*)(lds + 18432 + 36864);
    LAS bf16* Ps = (LAS bf16*)(lds + 18432 + 36864 + 35840) + w * (16 * 168);
    const long rowbase = (long)b * SEQ + (long)nb * 128;
    const float* qg = A.in[I_QG] + l * 64; const float* kg = A.in[I_KG] + l * 64;
    const bool wr_state = (nb == 63) && ((qh & 1) == 0);
#pragma unroll
    for (int i = 0; i < 2; ++i) {
        const int c = tid + 512 * i, r = c >> 3, p = c & 7;
        const u32x4 raw = *(const u32x4*)(Z + (size_t)(rowbase + r) * INW + ZC_AQ + qh * 64 + p * 8);
        float f[8]; UNPACK8(raw, f);
        float ss = 0.f;
#pragma unroll
        for (int e = 0; e < 8; ++e) ss += f[e] * f[e];
        ss += __shfl_xor(ss, 1); ss += __shfl_xor(ss, 2); ss += __shfl_xor(ss, 4);
        const float rs = rsqrtf(ss * (1.f / 64.f) + EPS) * 0.125f;
#pragma unroll
        for (int e = 0; e < 8; ++e) f[e] = f[e] * rs * qg[p * 8 + e];
        *(LAS u32x4*)(Qs + r * 72 + p * 8) = PACK8(f);
    }
#pragma unroll
    for (int i = 0; i < 4; ++i) {
        const int c = tid + 512 * i, r = c >> 3, p = c & 7;
        const bool valid = (nb > 0) || (r >= 128);
        u32x4 rk = (u32x4){0u, 0u, 0u, 0u}, rv = (u32x4){0u, 0u, 0u, 0u};
        if (valid) { const bf16* zr = Z + (size_t)(rowbase - 128 + r) * INW; rk = *(const u32x4*)(zr + ZC_AK + kvh * 64 + p * 8); rv = *(const u32x4*)(zr + ZC_AV + kvh * 64 + p * 8); }
        float f[8]; UNPACK8(rk, f);
        float ss = 0.f;
#pragma unroll
        for (int e = 0; e < 8; ++e) ss += f[e] * f[e];
        ss += __shfl_xor(ss, 1); ss += __shfl_xor(ss, 2); ss += __shfl_xor(ss, 4);
        const float rs = rsqrtf(ss * (1.f / 64.f) + EPS);
#pragma unroll
        for (int e = 0; e < 8; ++e) f[e] = f[e] * rs * kg[p * 8 + e];
        *(LAS u32x4*)(Ks + r * 72 + p * 8) = PACK8(f);
        float fv[8]; UNPACK8(rv, fv);
#pragma unroll
        for (int e = 0; e < 8; ++e) Vt[(p * 8 + e) * 280 + r] = (bf16)f2bf(fv[e]);
        if (wr_state && r >= 128) {
            float* kp = A.out + O_KP + ((size_t)((l * 2 + b) * 128 + (r - 128)) * 2 + kvh) * 64 + p * 8;
            float* vp = A.out + O_VP + ((size_t)((l * 2 + b) * 128 + (r - 128)) * 2 + kvh) * 64 + p * 8;
            *(f32x4*)kp = (f32x4){f[0], f[1], f[2], f[3]}; *(f32x4*)(kp + 4) = (f32x4){f[4], f[5], f[6], f[7]};
            *(f32x4*)vp = (f32x4){fv[0], fv[1], fv[2], fv[3]}; *(f32x4*)(vp + 4) = (f32x4){fv[4], fv[5], fv[6], fv[7]};
        }
    }
    for (int idx = tid; idx < 64 * 24; idx += NTHR) { const int row = idx / 24, c = 256 + idx % 24; Vt[row * 280 + c] = 0; }
    __syncthreads();
    bf16x8 qf[2];
#pragma unroll
    for (int kk = 0; kk < 2; ++kk) qf[kk] = *(const LAS bf16x8*)(Qs + (16 * w + li) * 72 + kk * 32 + lq * 8);
    f32x4 s[9];
#pragma unroll
    for (int nt = 0; nt < 9; ++nt) { s[nt] = (f32x4){0.f, 0.f, 0.f, 0.f};
#pragma unroll
        for (int kk = 0; kk < 2; ++kk) { const bf16x8 kf = *(const LAS bf16x8*)(Ks + (16 * (w + nt) + li) * 72 + kk * 32 + lq * 8); s[nt] = MFMA16(kf, qf[kk], s[nt]); } }
    const float slope = exp2f(-2.f * (float)(qh + 1)), sink = A.in[I_SINK][l * 4 + qh];
    float mx = sink;
#pragma unroll
    for (int nt = 0; nt < 9; ++nt)
#pragma unroll
        for (int r = 0; r < 4; ++r) {
            const int dist = 128 + li - 16 * nt - lq * 4 - r, jk = 16 * (w + nt) + lq * 4 + r;
            const bool ok = dist >= 0 && dist <= 128 && (nb > 0 || jk >= 128);
            const float v = ok ? s[nt][r] - slope * (float)dist : -INFINITY;
            s[nt][r] = v; mx = fmaxf(mx, v);
        }
    mx = fmaxf(mx, __shfl_xor(mx, 16)); mx = fmaxf(mx, __shfl_xor(mx, 32));
    float sum = 0.f;
#pragma unroll
    for (int nt = 0; nt < 9; ++nt)
#pragma unroll
        for (int r = 0; r < 4; ++r) { const float p = __expf(s[nt][r] - mx); s[nt][r] = p; sum += p; }
    sum += __shfl_xor(sum, 16); sum += __shfl_xor(sum, 32);
    const float inv = 1.f / (sum + __expf(sink - mx));
#pragma unroll
    for (int nt = 0; nt < 9; ++nt) { u32x2 pk; pk.x = pk2(s[nt][0] * inv, s[nt][1] * inv); pk.y = pk2(s[nt][2] * inv, s[nt][3] * inv);
        *(LAS u32x2*)(Ps + li * 168 + 16 * nt + lq * 4) = pk; }
    *(LAS u32x2*)(Ps + li * 168 + 144 + lq * 4) = (u32x2){0u, 0u};
    LDS_WAIT();
    f32x4 o[4];
#pragma unroll
    for (int dt = 0; dt < 4; ++dt) o[dt] = (f32x4){0.f, 0.f, 0.f, 0.f};
#pragma unroll
    for (int ks = 0; ks < 5; ++ks) { const bf16x8 pf = *(const LAS bf16x8*)(Ps + li * 168 + ks * 32 + lq * 8);
#pragma unroll
        for (int dt = 0; dt < 4; ++dt) { const bf16x8 vf = *(const LAS bf16x8*)(Vt + (16 * dt + li) * 280 + 16 * w + ks * 32 + lq * 8); o[dt] = MFMA16(vf, pf, o[dt]); } }
    bf16* orow = MIX + (size_t)(rowbase + 16 * w + li) * D + 256 + qh * 64 + lq * 4;
#pragma unroll
    for (int dt = 0; dt < 4; ++dt) { u32x2 pk; pk.x = pk2(o[dt][0], o[dt][1]); pk.y = pk2(o[dt][2], o[dt][3]); *(u32x2*)(orow + 16 * dt) = pk; }
    __syncthreads();
}

__device__ __forceinline__ void retkv_unit(LAS unsigned char* lds, const Args& A, int unit, int tid) {
    asm volatile("" : "+v"(tid));
    const int c = unit & 63, h = (unit >> 6) & 3, b = unit >> 8;
    const int lane = tid & 63, w = tid >> 6, li = lane & 15, lq = lane >> 4;
    const bf16* Z = (const bf16*)(A.ws + WS_Z);
    float* KV = (float*)(A.ws + WS_KV) + (size_t)((b * 4 + h) * 64 + c) * 4096;
    LAS bf16* Kt = (LAS bf16*)lds;
    LAS bf16* Vt = (LAS bf16*)(lds + 64 * 136 * 2);
    const size_t rowbase = (size_t)b * SEQ + (size_t)c * 128;
    const float l2g = log2gamma(h);
#pragma unroll
    for (int i = 0; i < 2; ++i) {
        const int ci = tid + 512 * i, j = ci >> 3, p = ci & 7;
        const bf16* zr = Z + (rowbase + j) * INW;
        const u32x4 rk = *(const u32x4*)(zr + ZC_RK + h * 64 + p * 8), rv = *(const u32x4*)(zr + ZC_RV + h * 64 + p * 8);
        float fk[8], fv[8]; UNPACK8(rk, fk); UNPACK8(rv, fv);
        const float sc = 0.125f * exp2f((float)(127 - j) * l2g);
#pragma unroll
        for (int e = 0; e < 8; ++e) { Kt[(p * 8 + e) * 136 + j] = (bf16)f2bf(fk[e] * sc); Vt[(p * 8 + e) * 136 + j] = (bf16)f2bf(fv[e]); }
    }
    __syncthreads();
    const int dtile = w & 3, eh = w >> 2;
    f32x4 acc[2] = {(f32x4){0.f, 0.f, 0.f, 0.f}, (f32x4){0.f, 0.f, 0.f, 0.f}};
#pragma unroll
    for (int ks = 0; ks < 4; ++ks) { const bf16x8 kf = *(const LAS bf16x8*)(Kt + (16 * dtile + li) * 136 + ks * 32 + lq * 8);
#pragma unroll
        for (int n = 0; n < 2; ++n) { const bf16x8 vf = *(const LAS bf16x8*)(Vt + (16 * (eh * 2 + n) + li) * 136 + ks * 32 + lq * 8); acc[n] = MFMA16(vf, kf, acc[n]); } }
#pragma unroll
    for (int n = 0; n < 2; ++n) *(f32x4*)(KV + (16 * dtile + li) * 64 + 16 * (eh * 2 + n) + lq * 4) = acc[n];
    __syncthreads();
}

__device__ __forceinline__ void retout_unit(LAS unsigned char* lds, const Args& A, int l, int unit, int tid) {
    asm volatile("" : "+v"(tid));
    const int c = unit & 63, h = (unit >> 6) & 3, b = unit >> 8;
    const int lane = tid & 63, w = tid >> 6, li = lane & 15, lq = lane >> 4;
    const bf16* Z = (const bf16*)(A.ws + WS_Z);
    bf16* MIX = (bf16*)(A.ws + WS_MIX);
    const float* KVb = (const float*)(A.ws + WS_KV) + (size_t)((b * 4 + h) * 64) * 4096;
    LAS bf16* Qs = (LAS bf16*)lds;
    LAS bf16* Ks = (LAS bf16*)(lds + 18432);
    LAS bf16* Bt = (LAS bf16*)(lds + 36864);
    LAS bf16* P = (LAS bf16*)(lds + 62464) + w * (16 * 200);
    const size_t rowbase = (size_t)b * SEQ + (size_t)c * 128;
    const float l2g = log2gamma(h);
#pragma unroll
    for (int i = 0; i < 2; ++i) {
        const int ci = tid + 512 * i, j = ci >> 3, p = ci & 7;
        const bf16* zr = Z + (rowbase + j) * INW;
        const u32x4 rq = *(const u32x4*)(zr + ZC_RQ + h * 64 + p * 8), rk = *(const u32x4*)(zr + ZC_RK + h * 64 + p * 8), rv = *(const u32x4*)(zr + ZC_RV + h * 64 + p * 8);
        *(LAS u32x4*)(Qs + j * 72 + p * 8) = rq;
        float fk[8]; UNPACK8(rk, fk);
#pragma unroll
        for (int e = 0; e < 8; ++e) fk[e] *= 0.125f;
        *(LAS u32x4*)(Ks + j * 72 + p * 8) = PACK8(fk);
        float fv[8]; UNPACK8(rv, fv);
#pragma unroll
        for (int e = 0; e < 8; ++e) Bt[(p * 8 + e) * 200 + j] = (bf16)f2bf(fv[e]);
    }
    {
        const float g128 = exp2f(128.f * l2g);
        f32x4 s0 = (f32x4){0.f, 0.f, 0.f, 0.f}, s1 = s0;
        const float* kp = KVb + tid * 8;
        int j = 0;
        for (; j + 8 <= c; j += 8) { f32x4 a[8], bq[8];
#pragma unroll
            for (int u = 0; u < 8; ++u) { a[u] = *(const f32x4*)(kp + (size_t)(j + u) * 4096); bq[u] = *(const f32x4*)(kp + (size_t)(j + u) * 4096 + 4); }
#pragma unroll
            for (int u = 0; u < 8; ++u) { s0 = s0 * g128 + a[u]; s1 = s1 * g128 + bq[u]; } }
        for (; j < c; ++j) { const f32x4 a = *(const f32x4*)(kp + (size_t)j * 4096), bq = *(const f32x4*)(kp + (size_t)j * 4096 + 4); s0 = s0 * g128 + a; s1 = s1 * g128 + bq; }
        const int d = tid >> 3, e0 = (tid & 7) * 8;
        Bt[(e0 + 0) * 200 + 128 + d] = (bf16)f2bf(s0.x); Bt[(e0 + 1) * 200 + 128 + d] = (bf16)f2bf(s0.y); Bt[(e0 + 2) * 200 + 128 + d] = (bf16)f2bf(s0.z); Bt[(e0 + 3) * 200 + 128 + d] = (bf16)f2bf(s0.w);
        Bt[(e0 + 4) * 200 + 128 + d] = (bf16)f2bf(s1.x); Bt[(e0 + 5) * 200 + 128 + d] = (bf16)f2bf(s1.y); Bt[(e0 + 6) * 200 + 128 + d] = (bf16)f2bf(s1.z); Bt[(e0 + 7) * 200 + 128 + d] = (bf16)f2bf(s1.w);
        if (c == 63) {
            const f32x4 a = *(const f32x4*)(kp + (size_t)63 * 4096), bq = *(const f32x4*)(kp + (size_t)63 * 4096 + 4);
            float* rp = A.out + O_RETP + (size_t)((l * 2 + b) * 4 + h) * 4096 + tid * 8;
            *(f32x4*)rp = s0 * g128 + a; *(f32x4*)(rp + 4) = s1 * g128 + bq;
        }
    }
    __syncthreads();
    {
        const int i = 16 * w + li; const float qd = exp2f((float)(i + 1) * l2g);
#pragma unroll
        for (int hh = 0; hh < 2; ++hh) { const u32x4 rq = *(const LAS u32x4*)(Qs + i * 72 + lq * 16 + hh * 8); float f[8]; UNPACK8(rq, f);
#pragma unroll
            for (int e = 0; e < 8; ++e) f[e] *= qd;
            *(LAS u32x4*)(P + li * 200 + 128 + lq * 16 + hh * 8) = PACK8(f); }
    }
    bf16x8 qf[2];
#pragma unroll
    for (int kk = 0; kk < 2; ++kk) qf[kk] = *(const LAS bf16x8*)(Qs + (16 * w + li) * 72 + kk * 32 + lq * 8);
#pragma unroll
    for (int nt = 0; nt < 8; ++nt) {
        u32x2 pk = (u32x2){0u, 0u};
        if (nt <= w) {
            f32x4 acc = (f32x4){0.f, 0.f, 0.f, 0.f};
#pragma unroll
            for (int kk = 0; kk < 2; ++kk) { const bf16x8 kf = *(const LAS bf16x8*)(Ks + (16 * nt + li) * 72 + kk * 32 + lq * 8); acc = MFMA16(kf, qf[kk], acc); }
            float v[4];
#pragma unroll
            for (int r = 0; r < 4; ++r) { const int diff = 16 * w + li - 16 * nt - lq * 4 - r; v[r] = diff >= 0 ? acc[r] * exp2f((float)diff * l2g) : 0.f; }
            pk.x = pk2(v[0], v[1]); pk.y = pk2(v[2], v[3]);
        }
        *(LAS u32x2*)(P + li * 200 + 16 * nt + lq * 4) = pk;
    }
    LDS_WAIT();
    f32x4 o[4];
#pragma unroll
    for (int dt = 0; dt < 4; ++dt) o[dt] = (f32x4){0.f, 0.f, 0.f, 0.f};
#pragma unroll
    for (int ks = 0; ks < 6; ++ks) { const bf16x8 pf = *(const LAS bf16x8*)(P + li * 200 + ks * 32 + lq * 8);
#pragma unroll
        for (int dt = 0; dt < 4; ++dt) { const bf16x8 bf = *(const LAS bf16x8*)(Bt + (16 * dt + li) * 200 + ks * 32 + lq * 8); o[dt] = MFMA16(bf, pf, o[dt]); } }
    float sm = 0.f;
#pragma unroll
    for (int dt = 0; dt < 4; ++dt) sm += (o[dt][0] + o[dt][1]) + (o[dt][2] + o[dt][3]);
    sm += __shfl_xor(sm, 16); sm += __shfl_xor(sm, 32);
    const float mean = sm * (1.f / 64.f);
    float q = 0.f;
#pragma unroll
    for (int dt = 0; dt < 4; ++dt) { o[dt] = o[dt] - mean; q += (o[dt][0] * o[dt][0] + o[dt][1] * o[dt][1]) + (o[dt][2] * o[dt][2] + o[dt][3] * o[dt][3]); }
    q += __shfl_xor(q, 16); q += __shfl_xor(q, 32);
    const float rstd = rsqrtf(q * (1.f / 64.f) + EPS);
    const size_t row = rowbase + 16 * w + li;
#pragma unroll
    for (int dt = 0; dt < 4; ++dt) {
        const u32x2 rg = *(const u32x2*)(Z + row * INW + ZC_RG + h * 64 + 16 * dt + lq * 4);
        const float g0 = bflo(rg.x), g1 = bfhi(rg.x), g2 = bflo(rg.y), g3 = bfhi(rg.y);
        u32x2 pk; pk.x = pk2(o[dt][0] * rstd * g0 * sigmoidf_(g0), o[dt][1] * rstd * g1 * sigmoidf_(g1)); pk.y = pk2(o[dt][2] * rstd * g2 * sigmoidf_(g2), o[dt][3] * rstd * g3 * sigmoidf_(g3));
        *(u32x2*)(MIX + row * D + h * 64 + 16 * dt + lq * 4) = pk;
    }
    __syncthreads();
}

__device__ __forceinline__ void conf_unit(LAS unsigned char* lds, const Args& A, int l, int unit, int tid) {
    asm volatile("" : "+v"(tid));
    const int tile = unit & 255, b = unit >> 8, t0 = tile * 32;
    const int lane = tid & 63, w = tid >> 6;
    const bf16* Z = (const bf16*)(A.ws + WS_Z);
    bf16* MIX = (bf16*)(A.ws + WS_MIX);
    LAS float* U = (LAS float*)lds;
    LAS float* Y = (LAS float*)(lds + 62 * 256 * 4);
    for (int idx = tid; idx < 62 * 32; idx += NTHR) {
        const int rr = idx >> 5, p = idx & 31, t = t0 - 30 + rr;
        float u[8];
#pragma unroll
        for (int e = 0; e < 8; ++e) u[e] = 0.f;
        if (t >= 0) {
            const bf16* zr = Z + ((size_t)b * SEQ + t) * INW;
            const u32x4 ra = *(const u32x4*)(zr + ZC_CA + p * 8), rb = *(const u32x4*)(zr + ZC_CB + p * 8);
            float fa[8], fb[8]; UNPACK8(ra, fa); UNPACK8(rb, fb);
#pragma unroll
            for (int e = 0; e < 8; ++e) u[e] = fa[e] * sigmoidf_(fb[e]);
        }
        *(LAS f32x4*)(U + rr * 256 + p * 8) = (f32x4){u[0], u[1], u[2], u[3]}; *(LAS f32x4*)(U + rr * 256 + p * 8 + 4) = (f32x4){u[4], u[5], u[6], u[7]};
        if (rr >= 30 && t >= SEQ - 30) { float* cp = A.out + O_CONFP + ((size_t)(l * 2 + b) * 30 + (t - (SEQ - 30))) * 256 + p * 8;
            *(f32x4*)cp = (f32x4){u[0], u[1], u[2], u[3]}; *(f32x4*)(cp + 4) = (f32x4){u[4], u[5], u[6], u[7]}; }
    }
    __syncthreads();
    {
        const int ch = tid & 255, half = tid >> 8;
        float wv[31];
#pragma unroll
        for (int j = 0; j < 31; ++j) wv[j] = A.in[I_CDW][(size_t)(l * 31 + j) * 256 + ch];
#pragma unroll
        for (int g = 0; g < 2; ++g) {
            const int base = half * 16 + g * 8;
            float uu[38];
#pragma unroll
            for (int k = 0; k < 38; ++k) uu[k] = U[(base + k) * 256 + ch];
#pragma unroll
            for (int o = 0; o < 8; ++o) { float acc = 0.f;
#pragma unroll
                for (int j = 0; j < 31; ++j) acc += wv[j] * uu[o + j];
                Y[(base + o) * 256 + ch] = acc; }
        }
    }
    __syncthreads();
    const f32x4 lg = *(const f32x4*)(A.in[I_CLG] + l * 256 + lane * 4), lb = *(const f32x4*)(A.in[I_CLB] + l * 256 + lane * 4);
#pragma unroll
    for (int tt = 0; tt < 4; ++tt) {
        const int tok = 4 * w + tt;
        f32x4 y = *(const LAS f32x4*)(Y + tok * 256 + lane * 4);
        const float mean = wave_sum((y.x + y.y) + (y.z + y.w)) * (1.f / 256.f);
        y = y - mean;
        const float rstd = rsqrtf(wave_sum((y.x * y.x + y.y * y.y) + (y.z * y.z + y.w * y.w)) * (1.f / 256.f) + EPS);
        const f32x4 v = y * rstd * lg + lb;
        u32x2 pk; pk.x = pk2(v.x * sigmoidf_(v.x), v.y * sigmoidf_(v.y)); pk.y = pk2(v.z * sigmoidf_(v.z), v.w * sigmoidf_(v.w));
        *(u32x2*)(MIX + ((size_t)b * SEQ + t0 + tok) * D + 512 + lane * 4) = pk;
    }
    __syncthreads();
}

__device__ __forceinline__ void sconv_unit(const Args& A, int l, int unit, int tid) {
    asm volatile("" : "+v"(tid));
    const int tile = unit & 127, b = unit >> 7;
    const bf16* Z = (const bf16*)(A.ws + WS_Z);
    bf16* MIX = (bf16*)(A.ws + WS_MIX);
    const int ch0 = (tid & 31) * 8;
    float w0[8], w1[8], w2[8];
#pragma unroll
    for (int e = 0; e < 8; ++e) { w0[e] = A.in[I_SDW][(l * 3 + 0) * 256 + ch0 + e]; w1[e] = A.in[I_SDW][(l * 3 + 1) * 256 + ch0 + e]; w2[e] = A.in[I_SDW][(l * 3 + 2) * 256 + ch0 + e]; }
#pragma unroll
    for (int i = 0; i < 4; ++i) {
        const int t = tile * 64 + (tid >> 5) + 16 * i;
        const size_t row = (size_t)b * SEQ + t;
        float g[3][8];
#pragma unroll
        for (int k = 0; k < 3; ++k) {
#pragma unroll
            for (int e = 0; e < 8; ++e) g[k][e] = 0.f;
            if (t - k >= 0) { const bf16* zr = Z + (row - k) * INW; const u32x4 rc = *(const u32x4*)(zr + ZC_SC + ch0), rh = *(const u32x4*)(zr + ZC_SH + ch0);
                float fc[8], fh[8]; UNPACK8(rc, fc); UNPACK8(rh, fh);
#pragma unroll
                for (int e = 0; e < 8; ++e) g[k][e] = fc[e] * fh[e]; }
        }
        const u32x4 rb = *(const u32x4*)(Z + row * INW + ZC_SB + ch0);
        float fb[8], o[8]; UNPACK8(rb, fb);
#pragma unroll
        for (int e = 0; e < 8; ++e) o[e] = fb[e] * (w0[e] * g[2][e] + w1[e] * g[1][e] + w2[e] * g[0][e]);
        *(u32x4*)(MIX + row * D + 768 + ch0) = PACK8(o);
        if (t >= SEQ - 2) { float* sp = A.out + O_SCP + ((size_t)(l * 2 + b) * 2 + (t - (SEQ - 2))) * 256 + ch0;
            *(f32x4*)sp = (f32x4){g[0][0], g[0][1], g[0][2], g[0][3]}; *(f32x4*)(sp + 4) = (f32x4){g[0][4], g[0][5], g[0][6], g[0][7]}; }
    }
}

__device__ __forceinline__ void sample_unit(LAS unsigned char* lds, const Args& A, int l, int b, int tid) {
    asm volatile("" : "+v"(tid));
    const int lane = tid & 63, w = tid >> 6;
    const bf16* Z = (const bf16*)(A.ws + WS_Z);
    bf16* MIX = (bf16*)(A.ws + WS_MIX);
    LAS float* Zs = (LAS float*)lds;
    LAS float* KD = (LAS float*)(lds + 90112);
    LAS float* Qn = (LAS float*)(lds + 98304);
    LAS float* Kn = (LAS float*)(lds + 106496);
    LAS float* Sc = (LAS float*)(lds + 110592);
    LAS float* Y = Sc;
    LAS float* PART = (LAS float*)(lds + 128000);
    LAS float* ATT = (LAS float*)(lds + 144384);
    const size_t row0 = (size_t)TP + (size_t)b * 8;
    const size_t lb = (size_t)l * 128 + b;
    for (int idx = tid; idx < 8 * 352; idx += NTHR) { const int r = idx / 352, p = idx % 352;
        const u32x4 raw = *(const u32x4*)(Z + (row0 + r) * INW + p * 8); float f[8]; UNPACK8(raw, f);
        *(LAS f32x4*)(Zs + r * INW + p * 8) = (f32x4){f[0], f[1], f[2], f[3]}; *(LAS f32x4*)(Zs + r * INW + p * 8 + 4) = (f32x4){f[4], f[5], f[6], f[7]}; }
    __syncthreads();
    if (tid < 256) {
        const int ch = tid;
        float xp[10];
        xp[0] = A.in[I_SSC][(lb * 2 + 0) * 256 + ch]; xp[1] = A.in[I_SSC][(lb * 2 + 1) * 256 + ch];
#pragma unroll
        for (int t = 0; t < 8; ++t) xp[2 + t] = Zs[t * INW + ZC_SC + ch] * Zs[t * INW + ZC_SH + ch];
        const float w0 = A.in[I_SDW][(l * 3 + 0) * 256 + ch], w1 = A.in[I_SDW][(l * 3 + 1) * 256 + ch], w2 = A.in[I_SDW][(l * 3 + 2) * 256 + ch];
#pragma unroll
        for (int t = 0; t < 8; ++t) { const float y = w0 * xp[t] + w1 * xp[t + 1] + w2 * xp[t + 2];
            MIX[(row0 + t) * D + 768 + ch] = (bf16)f2bf(Zs[t * INW + ZC_SB + ch] * y); }
        A.out[O_SCS + (lb * 2 + 0) * 256 + ch] = xp[8]; A.out[O_SCS + (lb * 2 + 1) * 256 + ch] = xp[9];
    } else {
        const int ch = tid - 256;
        float xp[38];
#pragma unroll
        for (int k = 0; k < 30; ++k) xp[k] = A.in[I_SCONF][(lb * 30 + k) * 256 + ch];
#pragma unroll
        for (int t = 0; t < 8; ++t) xp[30 + t] = Zs[t * INW + ZC_CA + ch] * sigmoidf_(Zs[t * INW + ZC_CB + ch]);
        float acc[8];
#pragma unroll
        for (int t = 0; t < 8; ++t) acc[t] = 0.f;
#pragma unroll
        for (int j = 0; j < 31; ++j) { const float wj = A.in[I_CDW][(size_t)(l * 31 + j) * 256 + ch];
#pragma unroll
            for (int t = 0; t < 8; ++t) acc[t] += wj * xp[t + j]; }
#pragma unroll
        for (int t = 0; t < 8; ++t) Y[t * 256 + ch] = acc[t];
#pragma unroll
        for (int i = 0; i < 30; ++i) A.out[O_CONFS + (lb * 30 + i) * 256 + ch] = xp[8 + i];
    }
#pragma unroll
    for (int i = 0; i < 6; ++i) {
        const int v = w * 6 + i;
        if (v < 32) { const int t = v >> 2, h = v & 3; const float x = Zs[t * INW + ZC_AQ + h * 64 + lane];
            const float rs = rsqrtf(wave_sum(x * x) * (1.f / 64.f) + EPS) * 0.125f; Qn[t * 256 + h * 64 + lane] = x * rs * A.in[I_QG][l * 64 + lane]; }
        else { const int v2 = v - 32, t = v2 >> 1, kh = v2 & 1; const float x = Zs[t * INW + ZC_AK + kh * 64 + lane];
            const float rs = rsqrtf(wave_sum(x * x) * (1.f / 64.f) + EPS); Kn[t * 128 + kh * 64 + lane] = x * rs * A.in[I_KG][l * 64 + lane]; }
    }
#pragma unroll
    for (int i = 0; i < 4; ++i) { const int idx = tid + 512 * i, j = idx >> 8, c = idx & 255;
        KD[idx] = Zs[j * INW + ZC_RK + c] * 0.125f * exp2f((float)(7 - j) * log2gamma(c >> 6)); }
    if (tid < 256) { const int h = tid >> 6, i = (tid >> 3) & 7, j = tid & 7;
        float dot = 0.f;
        for (int d = 0; d < 64; ++d) dot += Zs[i * INW + ZC_RQ + h * 64 + d] * Zs[j * INW + ZC_RK + h * 64 + d];
        ATT[tid] = (j <= i) ? dot * 0.125f * exp2f((float)(i - j) * log2gamma(h)) : 0.f; }
    __syncthreads();
    {
        const f32x4 lg = *(const f32x4*)(A.in[I_CLG] + l * 256 + lane * 4), lbv = *(const f32x4*)(A.in[I_CLB] + l * 256 + lane * 4);
        f32x4 y = *(const LAS f32x4*)(Y + w * 256 + lane * 4);
        const float mean = wave_sum((y.x + y.y) + (y.z + y.w)) * (1.f / 256.f);
        y = y - mean;
        const float rstd = rsqrtf(wave_sum((y.x * y.x + y.y * y.y) + (y.z * y.z + y.w * y.w)) * (1.f / 256.f) + EPS);
        const f32x4 v = y * rstd * lg + lbv;
        u32x2 pk; pk.x = pk2(v.x * sigmoidf_(v.x), v.y * sigmoidf_(v.y)); pk.y = pk2(v.z * sigmoidf_(v.z), v.w * sigmoidf_(v.w));
        *(u32x2*)(MIX + (row0 + w) * D + 512 + lane * 4) = pk;
    }
    {
        const int h = tid >> 7, e = tid & 63, dh = (tid >> 6) & 1;
        const float l2g = log2gamma(h), cdec = exp2f(8.f * l2g);
        float v[8], accq[8];
#pragma unroll
        for (int j = 0; j < 8; ++j) { v[j] = Zs[j * INW + ZC_RV + h * 64 + e]; accq[j] = 0.f; }
        const float* sp = A.in[I_SRET] + ((lb * 4 + h) * 64 + dh * 32) * 64 + e;
        float* op = A.out + O_RETS + ((lb * 4 + h) * 64 + dh * 32) * 64 + e;
#pragma unroll 16
        for (int dd = 0; dd < 32; ++dd) {
            const int d = dh * 32 + dd;
            const float s = sp[dd * 64];
            float sn = s * cdec;
#pragma unroll
            for (int t = 0; t < 8; ++t) { accq[t] += Zs[t * INW + ZC_RQ + h * 64 + d] * s; sn += KD[t * 256 + h * 64 + d] * v[t]; }
            op[dd * 64] = sn;
        }
#pragma unroll
        for (int t = 0; t < 8; ++t) PART[((h * 2 + dh) * 8 + t) * 64 + e] = accq[t];
    }
    __syncthreads();
    {
        const int h = tid >> 7, e = tid & 63, tg = (tid >> 6) & 1;
        const float l2g = log2gamma(h);
#pragma unroll
        for (int tt = 0; tt < 4; ++tt) {
            const int t = tg * 4 + tt;
            float o = exp2f((float)(t + 1) * l2g) * (PART[((h * 2) * 8 + t) * 64 + e] + PART[((h * 2 + 1) * 8 + t) * 64 + e]);
#pragma unroll
            for (int j = 0; j < 8; ++j) o += ATT[h * 64 + t * 8 + j] * Zs[j * INW + ZC_RV + h * 64 + e];
            const float mean = wave_sum(o) * (1.f / 64.f);
            o -= mean;
            const float rstd = rsqrtf(wave_sum(o * o) * (1.f / 64.f) + EPS);
            const float g = Zs[t * INW + ZC_RG + h * 64 + e];
            MIX[(row0 + t) * D + h * 64 + e] = (bf16)f2bf(o * rstd * g * sigmoidf_(g));
        }
    }
    {
        const int kvh = tid >> 8, j = tid & 255;
        if (j < 136) {
            float key[64];
            if (j < 128) { const float* kp = A.in[I_CK] + ((lb * 128 + j) * 2 + kvh) * 64;
#pragma unroll
                for (int d4 = 0; d4 < 16; ++d4) { const f32x4 kv = *(const f32x4*)(kp + d4 * 4); key[d4 * 4] = kv.x; key[d4 * 4 + 1] = kv.y; key[d4 * 4 + 2] = kv.z; key[d4 * 4 + 3] = kv.w; } }
            else {
#pragma unroll
                for (int d4 = 0; d4 < 16; ++d4) { const f32x4 kv = *(const LAS f32x4*)(Kn + (j - 128) * 128 + kvh * 64 + d4 * 4); key[d4 * 4] = kv.x; key[d4 * 4 + 1] = kv.y; key[d4 * 4 + 2] = kv.z; key[d4 * 4 + 3] = kv.w; } }
#pragma unroll 1
            for (int gt = 0; gt < 16; ++gt) {
                const int g = gt >> 3, t = gt & 7, head = kvh * 2 + g;
                float dot = 0.f;
#pragma unroll
                for (int d4 = 0; d4 < 16; ++d4) { const f32x4 q = *(const LAS f32x4*)(Qn + t * 256 + head * 64 + d4 * 4);
                    dot += q.x * key[d4 * 4] + q.y * key[d4 * 4 + 1] + q.z * key[d4 * 4 + 2] + q.w * key[d4 * 4 + 3]; }
                const int dist = t + 128 - j;
                const float slope = exp2f(-2.f * (float)(head + 1));
                Sc[(kvh * 16 + gt) * 136 + j] = (dist >= 0 && dist <= 128) ? dot - slope * (float)dist : -INFINITY;
            }
        }
#pragma unroll
        for (int k = 0; k < 8; ++k) { const int idx4 = tid + 512 * k, i = idx4 >> 5, c4 = (idx4 & 31) * 4;
            f32x4 kk, vv;
            if (i < 120) { kk = *(const f32x4*)(A.in[I_CK] + (lb * 128 + i + 8) * 128 + c4); vv = *(const f32x4*)(A.in[I_CV] + (lb * 128 + i + 8) * 128 + c4); }
            else { kk = *(const LAS f32x4*)(Kn + (i - 120) * 128 + c4); vv = *(const LAS f32x4*)(Zs + (i - 120) * INW + ZC_AV + c4); }
            *(f32x4*)(A.out + O_KS + (lb * 128 + i) * 128 + c4) = kk; *(f32x4*)(A.out + O_VS + (lb * 128 + i) * 128 + c4) = vv; }
    }
    __syncthreads();
#pragma unroll
    for (int rr = 0; rr < 4; ++rr) {
        const int row = 4 * w + rr, head = (row >> 4) * 2 + ((row >> 3) & 1);
        const float sink = A.in[I_SINK][l * 4 + head];
        const float v0 = Sc[row * 136 + lane], v1 = Sc[row * 136 + 64 + lane], v2 = (lane < 8) ? Sc[row * 136 + 128 + lane] : -INFINITY;
        const float mx = fmaxf(wave_max(fmaxf(fmaxf(v0, v1), v2)), sink);
        const float p0 = __expf(v0 - mx), p1 = __expf(v1 - mx), p2 = __expf(v2 - mx);
        const float inv = 1.f / (wave_sum(p0 + p1 + p2) + __expf(sink - mx));
        Sc[row * 136 + lane] = p0 * inv; Sc[row * 136 + 64 + lane] = p1 * inv; if (lane < 8) Sc[row * 136 + 128 + lane] = p2 * inv;
    }
    __syncthreads();
    {
        const int kvh = tid >> 8, d = tid & 63, rg = (tid >> 6) & 3;
        float acc[4] = {0.f, 0.f, 0.f, 0.f};
        const float* vp = A.in[I_CV] + (lb * 128 * 2 + kvh) * 64 + d;
#pragma unroll 16
        for (int j = 0; j < 128; ++j) { const float v = vp[(size_t)j * 128];
#pragma unroll
            for (int rr = 0; rr < 4; ++rr) acc[rr] += Sc[(kvh * 16 + rg * 4 + rr) * 136 + j] * v; }
#pragma unroll
        for (int j = 0; j < 8; ++j) { const float v = Zs[j * INW + ZC_AV + kvh * 64 + d];
#pragma unroll
            for (int rr = 0; rr < 4; ++rr) acc[rr] += Sc[(kvh * 16 + rg * 4 + rr) * 136 + 128 + j] * v; }
#pragma unroll
        for (int rr = 0; rr < 4; ++rr) { const int r16 = rg * 4 + rr, g = r16 >> 3, t = r16 & 7;
            MIX[(row0 + t) * D + 256 + (kvh * 2 + g) * 64 + d] = (bf16)f2bf(acc[rr]); }
    }
    __syncthreads();
}

#define XB_TMO      128
#define XB_XCNT(j)  (256  + 64 * (j))
#define XB_XSUB(j)  (1280 + 64 * (j))
#define XB_XGEN(j)  (2304 + 64 * (j))
#define XB_TOP      3328
#define XB_TOPGEN   3392
#define XCD_BAR_WORDS 3456
#define XB_SPIN_CAP (1u << 18)

__device__ __forceinline__ unsigned xb_ld(unsigned* p)              { return __hip_atomic_load(p, __ATOMIC_RELAXED, __HIP_MEMORY_SCOPE_AGENT); }
__device__ __forceinline__ unsigned xb_add(unsigned* p, unsigned v) { return __hip_atomic_fetch_add(p, v, __ATOMIC_RELAXED, __HIP_MEMORY_SCOPE_AGENT); }
__device__ __forceinline__ unsigned xb_xcc_id() { return (unsigned)__builtin_amdgcn_s_getreg((3 << 11) | 20) & 0xFu; }
#define XB_SPIN(cond, bar) do { unsigned _sp = 0; while (cond) { __builtin_amdgcn_s_sleep(1); \
    if ((++_sp & 255u) == 0u) { if (xb_ld(&(bar)[XB_TMO])) break; if (_sp > XB_SPIN_CAP) { atomicAdd(&(bar)[XB_TMO], 1u); break; } } } } while (0)

struct XcdBarrier {
    unsigned* bar; unsigned x;
    volatile LAS unsigned* st;
};

__device__ __forceinline__ XcdBarrier xcd_barrier_post(unsigned* bar, volatile LAS unsigned* st) {
    XcdBarrier b; b.bar = bar; b.x = xb_xcc_id(); b.st = st;
    if (threadIdx.x == 0) (void)xb_add(&bar[XB_XCNT(b.x)], 1u);
    return b;
}
__device__ __forceinline__ void xcd_barrier_complete(unsigned* bar, unsigned x, unsigned& nloc, unsigned& nx) {
    const unsigned G = gridDim.x * gridDim.y * gridDim.z;
    unsigned sum, cnt, mine, sp = 0u;
    for (;;) {
        sum = 0u; cnt = 0u; mine = 0u;
#pragma unroll
        for (unsigned j = 0; j < 16; ++j) { const unsigned c = xb_ld(&bar[XB_XCNT(j)]); sum += c; cnt += (c > 0u) ? 1u : 0u; mine = (j == x) ? c : mine; }
        if (sum == G) break;
        __builtin_amdgcn_s_sleep(1);
        if ((++sp & 255u) == 0u) { if (xb_ld(&bar[XB_TMO])) break; if (sp > XB_SPIN_CAP) { atomicAdd(&bar[XB_TMO], 1u); break; } }
    }
    nloc = mine > 0u ? mine : 1u; nx = cnt > 0u ? cnt : 1u;
}

__device__ __forceinline__ void xcd_barrier(const XcdBarrier& b) {
    asm volatile("s_waitcnt vmcnt(0)" ::: "memory");
    __syncthreads();
    if (threadIdx.x == 0) {
        unsigned* bar = b.bar;
        __builtin_amdgcn_s_waitcnt(0);
        unsigned nloc = b.st[0], nx = b.st[1];
        if (nloc == 0u) { xcd_barrier_complete(bar, b.x, nloc, nx); b.st[0] = nloc; b.st[1] = nx; }
        const unsigned old = xb_add(&bar[XB_XSUB(b.x)], 1u);
        const unsigned gen = old / nloc;
        if (old + 1u == (gen + 1u) * nloc) {
            __builtin_amdgcn_fence(__ATOMIC_RELEASE, "agent");
            asm volatile("s_waitcnt vmcnt(0)" ::: "memory");
            const unsigned og = xb_add(&bar[XB_TOP], 1u);
            const unsigned tg = og / nx;
            if (og + 1u == (tg + 1u) * nx) xb_add(&bar[XB_TOPGEN], 1u);
            else XB_SPIN(xb_ld(&bar[XB_TOPGEN]) == tg, bar);
            __builtin_amdgcn_fence(__ATOMIC_ACQUIRE, "agent");
            xb_add(&bar[XB_XGEN(b.x)], 1u);
            asm volatile("s_waitcnt vmcnt(0)" ::: "memory");
        } else {
            XB_SPIN(xb_ld(&bar[XB_XGEN(b.x)]) == gen, bar);
            __builtin_amdgcn_fence(__ATOMIC_ACQUIRE, "agent");
            asm volatile("s_waitcnt vmcnt(0)" ::: "memory");
        }
    }
    __syncthreads();
}

__global__ void __launch_bounds__(NTHR) fwd_megakernel(Args A) {
    extern __shared__ __attribute__((aligned(16))) unsigned char lds_raw[];
    LAS unsigned char* lds = (LAS unsigned char*)lds_raw;
    cg::grid_group grid = cg::this_grid();
    const int tid = threadIdx.x;
    const int G = gridDim.x, bx = blockIdx.x;
    bf16* XN = (bf16*)(A.ws + WS_XN); bf16* Zb = (bf16*)(A.ws + WS_Z); bf16* MIX = (bf16*)(A.ws + WS_MIX); bf16* Hb = (bf16*)(A.ws + WS_H);

#ifndef PHMASK
#define PHMASK 0xFFFF
#endif
    if (tid < 16) ((LAS unsigned*)(lds + LDS_BYTES - 64))[tid] = 0u;
    __syncthreads();
    XcdBarrier bar = xcd_barrier_post((unsigned*)(A.ws + WS_CTL), (volatile LAS unsigned*)(lds + LDS_BYTES - 64));
    if (A.ws == nullptr) grid.sync();
#define GRID_BAR() xcd_barrier(bar)
#pragma unroll 1
    for (int ph = 0; ph < 17; ++ph) {
        const int l = (ph - 1) >> 3, s = (ph - 1) & 7;
        const float* mod = (const float*)(A.ws + WS_MOD) + (size_t)(l < 0 ? 0 : l) * NMODR * MODW;
        if (ph == 0) { if (PHMASK & 1) p0_prologue(lds, A, tid); }
        else if (s == 0) { if (PHMASK & 2) norm_phase(A, l, 0, tid); }
        else if (s == 1) { if (PHMASK & 4) {
            pg8::Gemm g{XN, (const bf16*)(A.ws + WS_WIN) + (size_t)l * INW * D, T, INW, D}; pg8::StaticOrder S; S.init(T, INW, G, bx);
            pg8::EpiBf16<0> E{Zb, INW};
            pg8::gemm_phase<pg8::EpiBf16<0>, pg8::StaticOrder, true, true>(lds, g, S, E); } }
        else if (s == 2) {
            for (int it = bx; it < 1920; it += G) {
                if (it < 128) { if (PHMASK & 8) sample_unit(lds, A, l, it, tid); }
                else if (it < 640) { if (PHMASK & 16) attn_unit(lds, A, l, it - 128, tid); }
                else if (it < 1152) { if (PHMASK & 32) conf_unit(lds, A, l, it - 640, tid); }
                else if (it < 1664) { if (PHMASK & 64) retkv_unit(lds, A, it - 1152, tid); }
                else { if (PHMASK & 128) sconv_unit(A, l, it - 1664, tid); }
            } }
        else if (s == 3) { if (PHMASK & 256) for (int it = bx; it < 512; it += G) retout_unit(lds, A, l, it, tid); }
        else if (s == 4) { if (PHMASK & 512) {
            pg8::Gemm g{MIX, (const bf16*)(A.ws + WS_WOUT) + (size_t)l * D * D, T, D, D}; pg8::StaticOrder S; S.init(T, D, G, bx);
            pg8::EpiRes E{l == 0 ? A.in[I_XP] : A.out, l == 0 ? A.in[I_XS] : A.out + (size_t)TP * D, A.out, mod + 2 * D, D, TP, MODW};
            pg8::gemm_phase<pg8::EpiRes, pg8::StaticOrder, true, true>(lds, g, S, E); } }
        else if (s == 5) { if (PHMASK & 2) norm_phase(A, l, 1, tid); }
        else if (s == 6) { if (PHMASK & 1024) {
            pg8::Gemm g{XN, (const bf16*)(A.ws + WS_W1) + (size_t)l * FF * D, T, FF, D}; pg8::StaticOrder S; S.init(T, FF, G, bx);
            pg8::EpiBf16<2> E{Hb, FF};
            pg8::gemm_phase<pg8::EpiBf16<2>, pg8::StaticOrder, true, true>(lds, g, S, E); } }
        else { if (PHMASK & 2048) {
            pg8::Gemm g{Hb, (const bf16*)(A.ws + WS_W2) + (size_t)l * D * FF, T, D, FF}; pg8::StaticOrder S; S.init(T, D, G, bx);
            pg8::EpiRes E{A.out, A.out + (size_t)TP * D, A.out, mod + 5 * D, D, TP, MODW};
            pg8::gemm_phase<pg8::EpiRes, pg8::StaticOrder, true, true>(lds, g, S, E); } }
        if (ph < 16) GRID_BAR();
    }
}

extern "C" void kernel_launch(void* const* d_in, const int* in_sizes, int n_in, void* d_out, int out_size, void* d_ws, size_t ws_size, hipStream_t stream) {
    static int grid = 0;
    if (grid == 0) {
        if (n_in != 24 || (size_t)out_size != O_END || ws_size < WS_END) { fprintf(stderr, "kernel_launch: unexpected shapes n_in %d out %d ws %zu\n", n_in, out_size, ws_size); grid = -1; return; }
        int dev = 0, cus = 0, per_cu = 0;
        hipGetDevice(&dev); hipDeviceGetAttribute(&cus, hipDeviceAttributeMultiprocessorCount, dev);
        hipFuncSetAttribute((const void*)fwd_megakernel, hipFuncAttributeMaxDynamicSharedMemorySize, LDS_BYTES);
        hipOccupancyMaxActiveBlocksPerMultiprocessor(&per_cu, (const void*)fwd_megakernel, NTHR, LDS_BYTES);
        if (per_cu < 1) { fprintf(stderr, "kernel_launch: occupancy query says %d blocks per CU\n", per_cu); per_cu = 1; }
        grid = cus;
        (void)hipGetLastError();
    }
    if (grid < 0) return;
    if (hipMemsetAsync((char*)d_ws + WS_CTL, 0, CTL_BYTES, stream) != hipSuccess) { fprintf(stderr, "memset failed\n"); return; }
    Args a{};
    for (int i = 0; i < 24; ++i) a.in[i] = (const float*)d_in[i];
    a.out = (float*)d_out; a.ws = (unsigned char*)d_ws;
    void* args[] = {&a};
    hipError_t e = hipLaunchCooperativeKernel((const void*)fwd_megakernel, dim3(grid), dim3(NTHR), args, LDS_BYTES, stream);
    if (e != hipSuccess) fprintf(stderr, "cooperative launch failed: %s (grid %d)\n", hipGetErrorString(e), grid);
}
```

```cpp
#include <hip/hip_runtime.h>
#include <hip/hip_cooperative_groups.h>
#include <cstdio>
#include <cstdint>
namespace cg = cooperative_groups;
namespace pg8 {
#define PG8_LAS __attribute__((address_space(3)))
typedef unsigned short bf16_t;
typedef short bf16x8 __attribute__((ext_vector_type(8)));
typedef float f32x4 __attribute__((ext_vector_type(4)));
typedef unsigned u32x4 __attribute__((ext_vector_type(4)));
constexpr int BM = 256, BK = 64, HALF = 128, HTB = HALF * BK * 2  , STAGE_BYTES = 8 * HTB, NXCD = 8, WGM = 8;

__host__ __device__ __forceinline__ int lds_byte(int r, int c) { const int st = (r >> 4) * 2 + (c >> 5), rr = r & 15, cc = c & 31, ob = rr * 64 + cc * 2; return st * 1024 + (ob ^ (((ob >> 9) & 1) << 5)); }
__host__ __device__ __forceinline__ void stage_rc(int b, int& R, int& C) { const int st = b / 1024, sb = b % 1024, swz = sb ^ (((sb >> 9) & 1) << 5); R = (st >> 1) * 16 + swz / 64; C = (st & 1) * 32 + (swz % 64) / 2; }
__host__ __device__ __forceinline__ int perm32(int rho) { const int n = rho >> 4, i = rho & 15; return 8 * (i >> 2) + 4 * n + (i & 3); }

struct Unit { int pm, pn, ks; };
struct Gemm { const bf16_t* A; const bf16_t* Bt; int M, N, K, ld; };

struct StaticOrder {
    int nM, nN, nwg, G, c;
    __host__ __device__ void init(int M, int N, int G_, int c_) { nM = M / BM; nN = N / BM; nwg = nM * nN; G = G_; c = c_; }
    __host__ __device__ bool next(int i, Unit& u) const {
        const long L = (long)i * G + c; if (L >= nwg) return false;
        int wgid = (int)L; { const int q = nwg / NXCD, r = nwg % NXCD, xcd = wgid % NXCD, off = wgid / NXCD; wgid = (xcd < r ? xcd * (q + 1) : r * (q + 1) + (xcd - r) * q) + off; }
        const int nig = WGM * nN, gid = wgid / nig, fm = gid * WGM, gsz = (nM - fm) < WGM ? (nM - fm) : WGM;
        u.pm = fm + ((wgid % nig) % gsz); u.pn = (wgid % nig) / gsz; u.ks = 0; return true;
    }
    __device__ __forceinline__ void a_ready(const Unit&) const {}
    __device__ __forceinline__ void done(const Unit&) const {}
};


struct SplitOrder {
    int pm0, nM, nN, nS, G, c;
    __host__ __device__ bool next(int i, Unit& u) const {
        const int L = i * G + c; if (L >= nM * nN * nS) return false;
        u.ks = L % nS; const int t = L / nS; u.pn = t % nN; u.pm = pm0 + t / nN; return true;
    }
    __device__ __forceinline__ void a_ready(const Unit&) const {}
    __device__ __forceinline__ void done(const Unit&) const {}
};

__device__ __forceinline__ unsigned cvt_pk_bf16(float lo, float hi) { unsigned r; asm volatile("v_cvt_pk_bf16_f32 %0, %1, %2" : "=v"(r) : "v"(lo), "v"(hi)); return r; }

template <int ACT  > struct EpiBf16 {
    static constexpr bool PERM = true, AFTER_DRAIN = false;
    bf16_t* O; int ldc;
    __device__ __forceinline__ void operator()(const f32x4 (&acc)[2][2][4][2], const Unit& u, int wr, int wc, int fr, int fq) const {
        const int row0 = u.pm * BM + wr * 64 + fr; const int col0 = u.pn * BM + wc * 32 + 8 * fq;
#pragma unroll
        for (int ai = 0; ai < 2; ++ai)
#pragma unroll
            for (int m = 0; m < 4; ++m) { bf16_t* rowp = O + (size_t)(row0 + ai * HALF + m * 16) * ldc + col0;
#pragma unroll
                for (int bj = 0; bj < 2; ++bj) { f32x4 v0 = acc[ai][bj][m][0], v1 = acc[ai][bj][m][1];
                    if (ACT == 2) {
#pragma unroll
                        for (int e = 0; e < 4; ++e) { float a = fmaxf(v0[e], 0.f), b = fmaxf(v1[e], 0.f); v0[e] = a * a; v1[e] = b * b; }
                    }
                    u32x4 w; w.x = cvt_pk_bf16(v0[0], v0[1]); w.y = cvt_pk_bf16(v0[2], v0[3]); w.z = cvt_pk_bf16(v1[0], v1[1]); w.w = cvt_pk_bf16(v1[2], v1[3]);
                    *(u32x4*)(rowp + bj * HALF) = w; } }
    }
};

struct EpiRes {
    static constexpr bool PERM = false, AFTER_DRAIN = false;
    const float* baseP; const float* baseS; float* out; const float* gate; int ldc; int tprows; int gstride;
    __device__ __forceinline__ void operator()(const f32x4 (&acc)[2][2][4][2], const Unit& u, int wr, int wc, int fr, int fq) const {
        const int col0 = u.pn * BM + wc * 32 + 4 * fq;
#pragma unroll
        for (int ai = 0; ai < 2; ++ai)
#pragma unroll
            for (int m = 0; m < 4; ++m) {
                const int row = u.pm * BM + ai * HALF + wr * 64 + m * 16 + fr;
                const int gr = row < tprows ? (row >> 13) : 2 + ((row - tprows) >> 3);
                const float* gp = gate + (size_t)gr * gstride + col0;
                const float* bp = (row < tprows ? baseP + (size_t)row * ldc : baseS + (size_t)(row - tprows) * ldc) + col0;
                float* op = out + (size_t)row * ldc + col0;
#pragma unroll
                for (int bj = 0; bj < 2; ++bj)
#pragma unroll
                    for (int n = 0; n < 2; ++n) { const int c = bj * HALF + n * 16;
                        const f32x4 g = *(const f32x4*)(gp + c); const f32x4 b = *(const f32x4*)(bp + c);
                        *(f32x4*)(op + c) = b + g * acc[ai][bj][m][n]; }
                asm volatile("" ::: "memory");
            }
    }
};

struct EpiPart {
    static constexpr bool PERM = false, AFTER_DRAIN = false;
    float* P; int row0, rows, ldc;
    __device__ __forceinline__ void operator()(const f32x4 (&acc)[2][2][4][2], const Unit& u, int wr, int wc, int fr, int fq) const {
        const int col0 = u.pn * BM + wc * 32 + 4 * fq;
#pragma unroll
        for (int ai = 0; ai < 2; ++ai)
#pragma unroll
            for (int m = 0; m < 4; ++m) {
                const int row = u.pm * BM + ai * HALF + wr * 64 + m * 16 + fr - row0;
                float* op = P + ((size_t)u.ks * rows + row) * ldc + col0;
#pragma unroll
                for (int bj = 0; bj < 2; ++bj)
#pragma unroll
                    for (int n = 0; n < 2; ++n) *(f32x4*)(op + bj * HALF + n * 16) = acc[ai][bj][m][n];
            }
    }
};
template <class Epi, class Sched, bool ALIGN_EPI = false, bool SP2 = false>
__device__ __forceinline__ void gemm_phase(PG8_LAS unsigned char* lds, const Gemm g, const Sched& S, const Epi& E) {
    int tid_l = threadIdx.x; asm volatile("" : "+v"(tid_l));
    const int tid = tid_l, wid = __builtin_amdgcn_readfirstlane(tid >> 6), lane = tid & 63, wr = wid >> 2, wc = wid & 3, fr = lane & 15, fq = lane >> 4;
    const int K = g.K, nt = K / BK;
    unsigned voffA[2], voffB[2];
#pragma unroll
    for (int i = 0; i < 2; ++i) { int R, C; stage_rc(tid * 16 + i * 8192, R, C); const int Rb = Epi::PERM ? ((R & ~31) + perm32(R & 31)) : R;
        voffA[i] = (unsigned)(R * g.ld + C) * 2u; voffB[i] = (unsigned)(Rb * g.ld + C) * 2u; }
    const size_t kstep = (size_t)(BK * 2);
    const size_t hstep = (size_t)HALF * g.ld * 2;
    const size_t tstep = 2 * hstep;
    const unsigned ldsw = (unsigned)wid * 1024u;
    const int aoff = lds_byte(wr * 64 + fr, fq * 8), boff = lds_byte(wc * 32 + fr, fq * 8);
#define PG8_SA(b, h) (((b) * 2 + (h)) * HTB)
#define PG8_SB(b, h) ((4 + (b) * 2 + (h)) * HTB)
#define PG8_STAGE(bufoff, gbase, voff) do { _Pragma("unroll") for (int _i = 0; _i < 2; ++_i) \
        __builtin_amdgcn_global_load_lds((const unsigned*)((const char*)(gbase) + (voff)[_i]), (PG8_LAS unsigned*)(lds + (bufoff) + ldsw + _i * 8192), 16, 0, 0); } while (0)
#define PG8_LDA(dst, b, h) do { _Pragma("unroll") for (int m = 0; m < 4; ++m) _Pragma("unroll") for (int k = 0; k < 2; ++k) dst[m][k] = *(const PG8_LAS bf16x8*)(lds + PG8_SA(b, h) + aoff + m * 2048 + k * 1024); } while (0)
#define PG8_LDB(dst, b, h) do { _Pragma("unroll") for (int n = 0; n < 2; ++n) _Pragma("unroll") for (int k = 0; k < 2; ++k) dst[n][k] = *(const PG8_LAS bf16x8*)(lds + PG8_SB(b, h) + boff + n * 2048 + k * 1024); } while (0)
#define PG8_MMA(ai, bj, At, Bt) do { __builtin_amdgcn_s_setprio(1); _Pragma("unroll") for (int m = 0; m < 4; ++m) _Pragma("unroll") for (int n = 0; n < 2; ++n) _Pragma("unroll") for (int k = 0; k < 2; ++k) \
        acc[ai][bj][m][n] = __builtin_amdgcn_mfma_f32_16x16x32_bf16(Bt[n][k], At[m][k], acc[ai][bj][m][n], 0, 0, 0); __builtin_amdgcn_s_setprio(0); } while (0)
#define PG8_WAIT_V(n) asm volatile("s_waitcnt vmcnt(" #n ")" ::: "memory")
#define PG8_WAIT_L(n) asm volatile("s_waitcnt lgkmcnt(" #n ")" ::: "memory")
#define PG8_BAR __builtin_amdgcn_s_barrier()
#define PG8_SCHED __builtin_amdgcn_sched_barrier(0)
    Unit cur, nxt; int ui = 0;
    if (!S.next(0, cur)) return;
    f32x4 acc[2][2][4][2];
#pragma unroll
    for (int a = 0; a < 2; ++a)
#pragma unroll
        for (int b = 0; b < 2; ++b)
#pragma unroll
            for (int m = 0; m < 4; ++m)
#pragma unroll
                for (int n = 0; n < 2; ++n) acc[a][b][m][n] = (f32x4){0.f, 0.f, 0.f, 0.f};
    bf16x8 At[4][2], B0[2][2], B1[2][2];
    const size_t sstep = (size_t)K * 2;
    const char* cA = (const char*)g.A + (size_t)cur.pm * tstep + (size_t)cur.ks * sstep; const char* cB = (const char*)g.Bt + (size_t)cur.pn * tstep + (size_t)cur.ks * sstep;
    S.a_ready(cur);
    if constexpr (SP2) {
        PG8_STAGE(PG8_SB(0, 0), cB, voffB); PG8_STAGE(PG8_SB(0, 1), cB + hstep, voffB); PG8_STAGE(PG8_SA(0, 0), cA, voffA); PG8_STAGE(PG8_SA(0, 1), cA + hstep, voffA);
        if (wr == 1) PG8_BAR;
        PG8_WAIT_V(2); PG8_BAR;
        PG8_STAGE(PG8_SB(1, 0), cB + kstep, voffB); PG8_STAGE(PG8_SA(1, 0), cA + kstep, voffA); PG8_STAGE(PG8_SB(1, 1), cB + hstep + kstep, voffB);
        PG8_WAIT_V(6); PG8_BAR;
    } else {
        PG8_STAGE(PG8_SB(0, 0), cB, voffB); PG8_STAGE(PG8_SA(0, 0), cA, voffA); PG8_STAGE(PG8_SB(0, 1), cB + hstep, voffB); PG8_STAGE(PG8_SA(0, 1), cA + hstep, voffA);
        if (wr == 1) PG8_BAR;
        PG8_WAIT_V(4); PG8_BAR;
        PG8_STAGE(PG8_SB(1, 0), cB + kstep, voffB); PG8_STAGE(PG8_SA(1, 0), cA + kstep, voffA); PG8_STAGE(PG8_SB(1, 1), cB + hstep + kstep, voffB);
        PG8_WAIT_V(6); PG8_BAR;
    }
    for (;;) {
        const bool has_next = S.next(ui + 1, nxt);
        const char* nA = has_next ? (const char*)g.A + (size_t)nxt.pm * tstep + (size_t)nxt.ks * sstep : cA; const char* nB = has_next ? (const char*)g.Bt + (size_t)nxt.pn * tstep + (size_t)nxt.ks * sstep : cB;
        for (int t = 0; t < nt; t += 2) {
            const bool last = (t == nt - 2);
            const char* a1 = cA + (size_t)(t + 1) * kstep;
            const char* a2 = last ? nA : cA + (size_t)(t + 2) * kstep; const char* b2 = last ? nB : cB + (size_t)(t + 2) * kstep;
            const char* a3 = a2 + kstep; const char* b3 = b2 + kstep;
            if (last && has_next) S.a_ready(nxt);
            if constexpr (SP2) {
            PG8_LDB(B0, 0, 0); PG8_LDB(B1, 0, 1); PG8_SCHED; PG8_LDA(At, 0, 0); PG8_STAGE(PG8_SA(1, 1), a1 + hstep, voffA);
            PG8_WAIT_V(8); PG8_WAIT_L(0); PG8_BAR; PG8_MMA(0, 0, At, B0); PG8_MMA(0, 1, At, B1); PG8_BAR; PG8_SCHED;
            PG8_LDA(At, 0, 1); PG8_STAGE(PG8_SB(0, 0), b2, voffB); PG8_STAGE(PG8_SB(0, 1), b2 + hstep, voffB); PG8_STAGE(PG8_SA(0, 0), a2, voffA);
            PG8_WAIT_V(8); PG8_WAIT_L(0); PG8_BAR; PG8_MMA(1, 0, At, B0); PG8_MMA(1, 1, At, B1); PG8_BAR; PG8_SCHED;
            PG8_LDB(B0, 1, 0); PG8_LDB(B1, 1, 1); PG8_SCHED; PG8_LDA(At, 1, 0); PG8_STAGE(PG8_SA(0, 1), a2 + hstep, voffA);
            PG8_WAIT_V(8); PG8_WAIT_L(0); PG8_BAR; PG8_MMA(0, 0, At, B0); PG8_MMA(0, 1, At, B1); PG8_BAR; PG8_SCHED;
            PG8_LDA(At, 1, 1); PG8_STAGE(PG8_SB(1, 0), b3, voffB); PG8_STAGE(PG8_SB(1, 1), b3 + hstep, voffB); PG8_STAGE(PG8_SA(1, 0), a3, voffA);
            PG8_WAIT_V(8); PG8_WAIT_L(0); PG8_BAR; PG8_MMA(1, 0, At, B0); PG8_MMA(1, 1, At, B1); PG8_BAR; PG8_SCHED;
            } else {
            PG8_LDB(B0, 0, 0); PG8_SCHED; PG8_LDA(At, 0, 0); PG8_STAGE(PG8_SA(1, 1), a1 + hstep, voffA);
            PG8_WAIT_L(8); PG8_BAR; PG8_WAIT_L(0); PG8_MMA(0, 0, At, B0); PG8_BAR; PG8_SCHED;
            PG8_LDB(B1, 0, 1); PG8_STAGE(PG8_SB(0, 0), b2, voffB);
            PG8_BAR; PG8_WAIT_L(0); PG8_MMA(0, 1, At, B1); PG8_BAR;
            PG8_LDA(At, 0, 1); PG8_STAGE(PG8_SA(0, 0), a2, voffA);
            PG8_BAR; PG8_WAIT_L(0); PG8_MMA(1, 0, At, B0); PG8_BAR; PG8_SCHED;
            PG8_STAGE(PG8_SB(0, 1), b2 + hstep, voffB);
            PG8_WAIT_V(6); PG8_BAR; PG8_MMA(1, 1, At, B1); PG8_BAR;
            PG8_LDB(B0, 1, 0); PG8_SCHED; PG8_LDA(At, 1, 0); PG8_STAGE(PG8_SA(0, 1), a2 + hstep, voffA);
            PG8_WAIT_L(8); PG8_BAR; PG8_WAIT_L(0); PG8_MMA(0, 0, At, B0); PG8_BAR; PG8_SCHED;
            PG8_LDB(B1, 1, 1); PG8_STAGE(PG8_SB(1, 0), b3, voffB);
            PG8_BAR; PG8_WAIT_L(0); PG8_MMA(0, 1, At, B1); PG8_BAR;
            PG8_LDA(At, 1, 1); PG8_STAGE(PG8_SA(1, 0), a3, voffA);
            PG8_BAR; PG8_WAIT_L(0); PG8_MMA(1, 0, At, B0); PG8_BAR; PG8_SCHED;
            PG8_STAGE(PG8_SB(1, 1), b3 + hstep, voffB);
            PG8_WAIT_V(6); PG8_BAR; PG8_MMA(1, 1, At, B1); PG8_BAR;
            }
        }
        if constexpr (ALIGN_EPI) { if (wr == 0) PG8_BAR; }
        if constexpr (!Epi::AFTER_DRAIN) { E(acc, cur, wr, wc, fr, fq); S.done(cur); }
        if (!has_next) break;
#pragma unroll
        for (int a = 0; a < 2; ++a)
#pragma unroll
            for (int b = 0; b < 2; ++b)
#pragma unroll
                for (int m = 0; m < 4; ++m)
#pragma unroll
                    for (int n = 0; n < 2; ++n) acc[a][b][m][n] = (f32x4){0.f, 0.f, 0.f, 0.f};
        cur = nxt; cA = nA; cB = nB; ++ui;
        if constexpr (ALIGN_EPI) { if (wr == 1) PG8_BAR; }
    }
    PG8_WAIT_V(0);
    if constexpr (!ALIGN_EPI) { if (wr == 0) PG8_BAR; }
    PG8_BAR;
    if constexpr (Epi::AFTER_DRAIN) { E.fused(acc, cur, wr, wc, fr, fq, lds, wid, lane); S.done(cur); }
#undef PG8_SA
#undef PG8_SB
#undef PG8_STAGE
#undef PG8_LDA
#undef PG8_LDB
#undef PG8_MMA
#undef PG8_WAIT_V
#undef PG8_WAIT_L
#undef PG8_BAR
#undef PG8_SCHED
}
}

#define LAS __attribute__((address_space(3)))
typedef unsigned short bf16;
typedef short bf16x8 __attribute__((ext_vector_type(8)));
typedef float f32x4 __attribute__((ext_vector_type(4)));
typedef unsigned u32x4 __attribute__((ext_vector_type(4)));
typedef unsigned u32x2 __attribute__((ext_vector_type(2)));

constexpr int NTHR = 512;
constexpr int D = 1024, SEQ = 8192, TP = 16384, TS = 1024, T = TP + TS, INW = 2816, FF = 4096, NL = 2;
constexpr int MODW = 6 * D, NMODR = 130;
constexpr float EPS = 1e-6f;
constexpr int ZC_RQ = 0, ZC_RK = 256, ZC_RV = 512, ZC_RG = 768, ZC_AQ = 1024, ZC_AK = 1280, ZC_AV = 1408, ZC_CA = 1536, ZC_CB = 1792, ZC_SB = 2048, ZC_SC = 2304, ZC_SH = 2560;
constexpr size_t O_YP = 0, O_YS = (size_t)TP * D, O_RETP = O_YS + (size_t)TS * D, O_KP = O_RETP + 2 * 2 * 4 * 4096, O_VP = O_KP + 2 * 2 * 128 * 128,
                 O_CONFP = O_VP + 2 * 2 * 128 * 128, O_SCP = O_CONFP + 2 * 2 * 30 * 256, O_RETS = O_SCP + 2 * 2 * 2 * 256, O_KS = O_RETS + (size_t)2 * 128 * 4 * 4096,
                 O_VS = O_KS + (size_t)2 * 128 * 128 * 128, O_CONFS = O_VS + (size_t)2 * 128 * 128 * 128, O_SCS = O_CONFS + (size_t)2 * 128 * 30 * 256, O_END = O_SCS + (size_t)2 * 128 * 2 * 256;
static_assert(O_END == 32735232, "output size");
constexpr size_t MiB = 1u << 20;
constexpr size_t WS_WIN = 0, WS_WOUT = WS_WIN + (size_t)NL * INW * D * 2, WS_W1 = WS_WOUT + (size_t)NL * D * D * 2, WS_W2 = WS_W1 + (size_t)NL * FF * D * 2, WS_MOD = WS_W2 + (size_t)NL * D * FF * 2,
                 WS_XN = WS_MOD + (size_t)NL * NMODR * MODW * 4, WS_H = WS_XN + (size_t)T * D * 2, WS_Z = WS_H, WS_MIX = WS_Z + (size_t)T * INW * 2, WS_KV = WS_MIX + (size_t)T * D * 2,
                 WS_P2 = WS_Z  , WS_CTL = WS_H + (size_t)T * FF * 2, WS_P4 = WS_CTL + 16384  ,
                 WS_END = WS_P4 + (size_t)8 * TS * D * 4;
constexpr size_t CTL_BYTES = 16384;
static_assert(WS_KV + (size_t)2 * 4 * 64 * 4096 * 4 <= WS_CTL && WS_P2 + (size_t)4 * TS * D * 4 <= WS_MIX && WS_END <= 256 * MiB && WS_XN % 256 == 0 && WS_H % 256 == 0 && WS_MIX % 256 == 0 && WS_P4 % 256 == 0, "ws map");
constexpr int LDS_BYTES = 147456;

struct Args { const float* in[24]; float* out; unsigned char* ws; };
enum { I_XP = 0, I_XS, I_CP, I_CS, I_SRET, I_CK, I_CV, I_SCONF, I_SSC, I_ADAW, I_ADAB, I_N1G, I_N2G, I_WIN, I_QG, I_KG, I_SINK, I_CDW, I_CLG, I_CLB, I_SDW, I_WOUT, I_WFF1, I_WFF2 };

__device__ __forceinline__ unsigned f2bf(float f) { unsigned u = __builtin_bit_cast(unsigned, f); return (u + 0x7fffu + ((u >> 16) & 1u)) >> 16; }
__device__ __forceinline__ unsigned pk2(float lo, float hi) { return f2bf(lo) | (f2bf(hi) << 16); }
__device__ __forceinline__ float bflo(unsigned u) { return __builtin_bit_cast(float, u << 16); }
__device__ __forceinline__ float bfhi(unsigned u) { return __builtin_bit_cast(float, u & 0xffff0000u); }
#define UNPACK8(raw, f) do { f[0] = bflo(raw.x); f[1] = bfhi(raw.x); f[2] = bflo(raw.y); f[3] = bfhi(raw.y); f[4] = bflo(raw.z); f[5] = bfhi(raw.z); f[6] = bflo(raw.w); f[7] = bfhi(raw.w); } while (0)
#define PACK8(f) ((u32x4){pk2(f[0], f[1]), pk2(f[2], f[3]), pk2(f[4], f[5]), pk2(f[6], f[7])})
#define LDS_WAIT() asm volatile("s_waitcnt lgkmcnt(0)" ::: "memory")
#define MFMA16(a, b, c) __builtin_amdgcn_mfma_f32_16x16x32_bf16((a), (b), (c), 0, 0, 0)
__device__ __forceinline__ float wave_sum(float v) {
#pragma unroll
    for (int o = 1; o < 64; o <<= 1) v += __shfl_xor(v, o);
    return v;
}
__device__ __forceinline__ float wave_max(float v) {
#pragma unroll
    for (int o = 1; o < 64; o <<= 1) v = fmaxf(v, __shfl_xor(v, o));
    return v;
}
__device__ __forceinline__ float sigmoidf_(float x) { return 1.f / (1.f + __expf(-x)); }
__device__ __forceinline__ float log2gamma(int h) { return log2f(1.f - exp2f(-5.f - (float)h)); }

__device__ __forceinline__ void p0_transpose_item(const float* W, int K, int N, bf16* WT, LAS float* scr, int item, int lane) {
    const int nblk = N / 32, kb = item / nblk, nb = item % nblk, k0 = 64 * kb, n0 = 32 * nb;
    float tv[32];
#pragma unroll
    for (int i = 0; i < 32; ++i) { const int kk = 2 * i + (lane >> 5); tv[i] = W[(size_t)(k0 + kk) * N + n0 + (lane & 31)]; }
#pragma unroll
    for (int i = 0; i < 32; ++i) { const int kk = 2 * i + (lane >> 5); scr[kk * 33 + (lane & 31)] = tv[i]; }
    LDS_WAIT();
    const int c = lane & 7;
#pragma unroll
    for (int j = 0; j < 4; ++j) { const int n = (lane >> 3) + 8 * j; const LAS float* s = scr + (8 * c) * 33 + n;
        u32x4 o; o.x = pk2(s[0 * 33], s[1 * 33]); o.y = pk2(s[2 * 33], s[3 * 33]); o.z = pk2(s[4 * 33], s[5 * 33]); o.w = pk2(s[6 * 33], s[7 * 33]);
        *(u32x4*)(WT + (size_t)(n0 + n) * K + k0 + 8 * c) = o; }
    LDS_WAIT();
}

constexpr int TR_IN = (D / 64) * (INW / 32), TR_O = (D / 64) * (D / 32), TR_1 = (D / 64) * (FF / 32), TR_2 = (FF / 64) * (D / 32), TR_PER_L = TR_IN + TR_O + TR_1 + TR_2;
__device__ __forceinline__ void transpose_dispatch(const Args& A, int it, LAS float* scr, int lane) {
    const int l = it / TR_PER_L; int r = it % TR_PER_L;
    if (r < TR_IN) { p0_transpose_item(A.in[I_WIN] + (size_t)l * D * INW, D, INW, (bf16*)(A.ws + WS_WIN) + (size_t)l * INW * D, scr, r, lane); return; } r -= TR_IN;
    if (r < TR_O) { p0_transpose_item(A.in[I_WOUT] + (size_t)l * D * D, D, D, (bf16*)(A.ws + WS_WOUT) + (size_t)l * D * D, scr, r, lane); return; } r -= TR_O;
    if (r < TR_1) { p0_transpose_item(A.in[I_WFF1] + (size_t)l * D * FF, D, FF, (bf16*)(A.ws + WS_W1) + (size_t)l * FF * D, scr, r, lane); return; } r -= TR_1;
    p0_transpose_item(A.in[I_WFF2] + (size_t)l * FF * D, FF, D, (bf16*)(A.ws + WS_W2) + (size_t)l * D * FF, scr, r, lane);
}

__device__ __forceinline__ void p0_mod_item(LAS unsigned char* lds, const Args& A, int item, int tid) {
    asm volatile("" : "+v"(tid));
    const int l = item / 96, cb = item % 96, col0 = cb * 64;
    const int lane = tid & 63, w = tid >> 6, li = lane & 15, lq = lane >> 4;
    LAS bf16* Wt = (LAS bf16*)lds;
    LAS bf16* SC = (LAS bf16*)(lds + 64 * 264 * 2);
    const float* aw = A.in[I_ADAW] + (size_t)l * D * MODW;
    const int ct = w & 3, rg = w >> 2;
    f32x4 acc[5];
#pragma unroll
    for (int i = 0; i < 5; ++i) acc[i] = (f32x4){0.f, 0.f, 0.f, 0.f};
    for (int kc = 0; kc < 4; ++kc) {
        const int k0 = kc * 256;
        {   float wv[32];
#pragma unroll
            for (int i = 0; i < 32; ++i) { const int kk = (tid >> 6) + 8 * i, c = tid & 63; wv[i] = aw[(size_t)(k0 + kk) * MODW + col0 + c]; }
#pragma unroll
            for (int hh = 0; hh < 2; ++hh) {
                f32x4 cv[9];
#pragma unroll
                for (int i = 0; i < 9; ++i) { const int idx = tid + 512 * (hh * 9 + i), r = idx >> 6, k4 = (idx & 63) * 4;
                    cv[i] = (f32x4){0.f, 0.f, 0.f, 0.f};
                    if (r < NMODR) cv[i] = *(const f32x4*)((r < 2) ? A.in[I_CP] + r * D + k0 + k4 : A.in[I_CS] + (size_t)(r - 2) * D + k0 + k4); }
#pragma unroll
                for (int i = 0; i < 9; ++i) { const int idx = tid + 512 * (hh * 9 + i), r = idx >> 6, k4 = (idx & 63) * 4;
                    u32x2 pk; pk.x = pk2(cv[i].x * sigmoidf_(cv[i].x), cv[i].y * sigmoidf_(cv[i].y)); pk.y = pk2(cv[i].z * sigmoidf_(cv[i].z), cv[i].w * sigmoidf_(cv[i].w));
                    *(LAS u32x2*)(SC + r * 264 + k4) = pk; }
            }
#pragma unroll
            for (int i = 0; i < 32; ++i) { const int kk = (tid >> 6) + 8 * i, c = tid & 63; Wt[c * 264 + kk] = (bf16)f2bf(wv[i]); }
        }
        __syncthreads();
#pragma unroll
        for (int ks = 0; ks < 8; ++ks) {
            const bf16x8 wf = *(const LAS bf16x8*)(Wt + (ct * 16 + li) * 264 + ks * 32 + lq * 8);
#pragma unroll
            for (int mi = 0; mi < 5; ++mi) { const int mt = rg * 5 + mi;
                if (mt < 9) { const bf16x8 sf = *(const LAS bf16x8*)(SC + (mt * 16 + li) * 264 + ks * 32 + lq * 8); acc[mi] = MFMA16(wf, sf, acc[mi]); } }
        }
        __syncthreads();
    }
    float* mod = (float*)(A.ws + WS_MOD) + (size_t)l * NMODR * MODW;
    const int col = col0 + ct * 16 + lq * 4;
    const f32x4 bias = *(const f32x4*)(A.in[I_ADAB] + (size_t)l * MODW + col);
#pragma unroll
    for (int mi = 0; mi < 5; ++mi) { const int r = (rg * 5 + mi) * 16 + li;
        if (rg * 5 + mi < 9 && r < NMODR) *(f32x4*)(mod + (size_t)r * MODW + col) = acc[mi] + bias; }
}

__device__ __forceinline__ void p0_prologue(LAS unsigned char* lds, const Args& A, int tid) {
    asm volatile("" : "+v"(tid));
    const int G = gridDim.x, bx = blockIdx.x;
    for (int it = bx; it < 192; it += G) p0_mod_item(lds, A, it, tid);
    __syncthreads();
    const int lane = tid & 63, wave = tid >> 6;
    LAS float* scr = (LAS float*)(lds + wave * 16384);
    int it0, it1;
    if (G == 256) { const int gw = bx * 8 + wave; if (bx < 192) { it0 = gw * 2; it1 = it0 + 2; } else { it0 = 3072 + (gw - 1536) * 6; it1 = it0 + 6; } }
    else { const int per = (TR_PER_L + G * 8 - 1) / (G * 8); it0 = (bx * 8 + wave) * per; it1 = it0 + per; }
    if (it1 > TR_PER_L) it1 = TR_PER_L;
    for (int it = it0; it < it1; ++it) transpose_dispatch(A, it, scr, lane);
}

__device__ __forceinline__ void norm_phase(const Args& A, int l, int which  , int tid) {
    asm volatile("" : "+v"(tid));
    const int lane = tid & 63, wave = tid >> 6;
    const int gw = blockIdx.x * 8 + wave, NGW = gridDim.x * 8;
    const bool fin = (l == NL);
    const int lm = fin ? NL - 1 : l;
    const float* modb = (const float*)(A.ws + WS_MOD);
    const float* gptr = A.in[which ? I_N2G : I_N1G] + (size_t)lm * D;
    const float* mod = modb + (size_t)lm * NMODR * MODW + (which ? 3 * D : 0);
    bf16* XN = (bf16*)(A.ws + WS_XN);
    const float* part = nullptr; const float* pgate = nullptr; int np = 0;
    if (which == 1) { part = (const float*)(A.ws + WS_P2); np = 4; pgate = modb + (size_t)l * NMODR * MODW + 2 * D; }
    else if (l > 0) { part = (const float*)(A.ws + WS_P4); np = 8; pgate = modb + (size_t)(l - 1) * NMODR * MODW + 5 * D; }
    for (int m = (fin ? TP : 0) + gw; m < T; m += NGW) {
        const float* xr; int r;
        if (m < TP) { r = m >> 13; xr = (l == 0 && which == 0) ? A.in[I_XP] + (size_t)m * D : A.out + (size_t)m * D; }
        else { r = 2 + ((m - TP) >> 3); xr = (l == 0) ? A.in[I_XS] + (size_t)(m - TP) * D : A.out + (size_t)m * D; }
        const float* mr = mod + (size_t)r * MODW;
        f32x4 v[4];
#pragma unroll
        for (int j = 0; j < 4; ++j) v[j] = *(const f32x4*)(xr + 4 * lane + 256 * j);
        if (m >= TP && np > 0) {
            const float* pr = part + (size_t)(m - TP) * D + 4 * lane;
            f32x4 acc[4];
#pragma unroll
            for (int j = 0; j < 4; ++j) acc[j] = (f32x4){0.f, 0.f, 0.f, 0.f};
            for (int s = 0; s < np; ++s) {
#pragma unroll
                for (int j = 0; j < 4; ++j) acc[j] += *(const f32x4*)(pr + (size_t)s * TS * D + 256 * j);
            }
#pragma unroll
            for (int j = 0; j < 4; ++j) { const f32x4 gt = *(const f32x4*)(pgate + (size_t)r * MODW + 4 * lane + 256 * j); v[j] += gt * acc[j];
                *(f32x4*)(A.out + (size_t)m * D + 4 * lane + 256 * j) = v[j]; }
        }
        if (fin) continue;
        float s = 0.f;
#pragma unroll
        for (int j = 0; j < 4; ++j) s += (v[j].x * v[j].x + v[j].y * v[j].y) + (v[j].z * v[j].z + v[j].w * v[j].w);
        const float rstd = rsqrtf(wave_sum(s) * (1.f / D) + EPS);
#pragma unroll
        for (int j = 0; j < 4; ++j) {
            const f32x4 sh = *(const f32x4*)(mr + 4 * lane + 256 * j), sc = *(const f32x4*)(mr + D + 4 * lane + 256 * j);
            const f32x4 gj = *(const f32x4*)(gptr + 4 * lane + 256 * j);
            const f32x4 o = v[j] * rstd * gj * (sc + 1.f) + sh;
            u32x2 pk; pk.x = pk2(o.x, o.y); pk.y = pk2(o.z, o.w);
            *(u32x2*)(XN + (size_t)m * D + 4 * lane + 256 * j) = pk;
        }
    }
}

__device__ __forceinline__ void attn_unit(LAS unsigned char* lds, const Args& A, int l, int unit, int tid) {
    asm volatile("" : "+v"(tid));
    const int qh = unit & 3, nb = (unit >> 2) & 63, b = unit >> 8, kvh = qh >> 1;
    const int lane = tid & 63, w = tid >> 6, li = lane & 15, lq = lane >> 4;
    const bf16* Z = (const bf16*)(A.ws + WS_Z);
    bf16* MIX = (bf16*)(A.ws + WS_MIX);
    LAS bf16* Qs = (LAS bf16*)lds;
    LAS bf16* Ks = (LAS bf16*)(lds + 18432);
    LAS bf16* Vt = (LAS bf16*)(lds + 18432 + 36864);
    LAS bf16* Ps = (LAS bf16*)(lds + 18432 + 36864 + 35840) + w * (16 * 168);
    const long rowbase = (long)b * SEQ + (long)nb * 128;
    const float* qg = A.in[I_QG] + l * 64; const float* kg = A.in[I_KG] + l * 64;
    const bool wr_state = (nb == 63) && ((qh & 1) == 0);
#pragma unroll
    for (int i = 0; i < 2; ++i) {
        const int c = tid + 512 * i, r = c >> 3, p = c & 7;
        const u32x4 raw = *(const u32x4*)(Z + (size_t)(rowbase + r) * INW + ZC_AQ + qh * 64 + p * 8);
        float f[8]; UNPACK8(raw, f);
        float ss = 0.f;
#pragma unroll
        for (int e = 0; e < 8; ++e) ss += f[e] * f[e];
        ss += __shfl_xor(ss, 1); ss += __shfl_xor(ss, 2); ss += __shfl_xor(ss, 4);
        const float rs = rsqrtf(ss * (1.f / 64.f) + EPS) * 0.125f;
#pragma unroll
        for (int e = 0; e < 8; ++e) f[e] = f[e] * rs * qg[p * 8 + e];
        *(LAS u32x4*)(Qs + r * 72 + p * 8) = PACK8(f);
    }
#pragma unroll
    for (int i = 0; i < 4; ++i) {
        const int c = tid + 512 * i, r = c >> 3, p = c & 7;
        const bool valid = (nb > 0) || (r >= 128);
        u32x4 rk = (u32x4){0u, 0u, 0u, 0u}, rv = (u32x4){0u, 0u, 0u, 0u};
        if (valid) { const bf16* zr = Z + (size_t)(rowbase - 128 + r) * INW; rk = *(const u32x4*)(zr + ZC_AK + kvh * 64 + p * 8); rv = *(const u32x4*)(zr + ZC_AV + kvh * 64 + p * 8); }
        float f[8]; UNPACK8(rk, f);
        float ss = 0.f;
#pragma unroll
        for (int e = 0; e < 8; ++e) ss += f[e] * f[e];
        ss += __shfl_xor(ss, 1); ss += __shfl_xor(ss, 2); ss += __shfl_xor(ss, 4);
        const float rs = rsqrtf(ss * (1.f / 64.f) + EPS);
#pragma unroll
        for (int e = 0; e < 8; ++e) f[e] = f[e] * rs * kg[p * 8 + e];
        *(LAS u32x4*)(Ks + r * 72 + p * 8) = PACK8(f);
        float fv[8]; UNPACK8(rv, fv);
#pragma unroll
        for (int e = 0; e < 8; ++e) Vt[(p * 8 + e) * 280 + r] = (bf16)f2bf(fv[e]);
        if (wr_state && r >= 128) {
            float* kp = A.out + O_KP + ((size_t)((l * 2 + b) * 128 + (r - 128)) * 2 + kvh) * 64 + p * 8;
            float* vp = A.out + O_VP + ((size_t)((l * 2 + b) * 128 + (r - 128)) * 2 + kvh) * 64 + p * 8;
            *(f32x4*)kp = (f32x4){f[0], f[1], f[2], f[3]}; *(f32x4*)(kp + 4) = (f32x4){f[4], f[5], f[6], f[7]};
            *(f32x4*)vp = (f32x4){fv[0], fv[1], fv[2], fv[3]}; *(f32x4*)(vp + 4) = (f32x4){fv[4], fv[5], fv[6], fv[7]};
        }
    }
    for (int idx = tid; idx < 64 * 24; idx += NTHR) { const int row = idx / 24, c = 256 + idx % 24; Vt[row * 280 + c] = 0; }
    __syncthreads();
    bf16x8 qf[2];
#pragma unroll
    for (int kk = 0; kk < 2; ++kk) qf[kk] = *(const LAS bf16x8*)(Qs + (16 * w + li) * 72 + kk * 32 + lq * 8);
    f32x4 s[9];
#pragma unroll
    for (int nt = 0; nt < 9; ++nt) { s[nt] = (f32x4){0.f, 0.f, 0.f, 0.f};
#pragma unroll
        for (int kk = 0; kk < 2; ++kk) { const bf16x8 kf = *(const LAS bf16x8*)(Ks + (16 * (w + nt) + li) * 72 + kk * 32 + lq * 8); s[nt] = MFMA16(kf, qf[kk], s[nt]); } }
    const float slope = exp2f(-2.f * (float)(qh + 1)), sink = A.in[I_SINK][l * 4 + qh];
    float mx = sink;
#pragma unroll
    for (int nt = 0; nt < 9; ++nt)
#pragma unroll
        for (int r = 0; r < 4; ++r) {
            const int dist = 128 + li - 16 * nt - lq * 4 - r, jk = 16 * (w + nt) + lq * 4 + r;
            const bool ok = dist >= 0 && dist <= 128 && (nb > 0 || jk >= 128);
            const float v = ok ? s[nt][r] - slope * (float)dist : -INFINITY;
            s[nt][r] = v; mx = fmaxf(mx, v);
        }
    mx = fmaxf(mx, __shfl_xor(mx, 16)); mx = fmaxf(mx, __shfl_xor(mx, 32));
    float sum = 0.f;
#pragma unroll
    for (int nt = 0; nt < 9; ++nt)
#pragma unroll
        for (int r = 0; r < 4; ++r) { const float p = __expf(s[nt][r] - mx); s[nt][r] = p; sum += p; }
    sum += __shfl_xor(sum, 16); sum += __shfl_xor(sum, 32);
    const float inv = 1.f / (sum + __expf(sink - mx));
#pragma unroll
    for (int nt = 0; nt < 9; ++nt) { u32x2 pk; pk.x = pk2(s[nt][0] * inv, s[nt][1] * inv); pk.y = pk2(s[nt][2] * inv, s[nt][3] * inv);
        *(LAS u32x2*)(Ps + li * 168 + 16 * nt + lq * 4) = pk; }
    *(LAS u32x2*)(Ps + li * 168 + 144 + lq * 4) = (u32x2){0u, 0u};
    LDS_WAIT();
    f32x4 o[4];
#pragma unroll
    for (int dt = 0; dt < 4; ++dt) o[dt] = (f32x4){0.f, 0.f, 0.f, 0.f};
#pragma unroll
    for (int ks = 0; ks < 5; ++ks) { const bf16x8 pf = *(const LAS bf16x8*)(Ps + li * 168 + ks * 32 + lq * 8);
#pragma unroll
        for (int dt = 0; dt < 4; ++dt) { const bf16x8 vf = *(const LAS bf16x8*)(Vt + (16 * dt + li) * 280 + 16 * w + ks * 32 + lq * 8); o[dt] = MFMA16(vf, pf, o[dt]); } }
    bf16* orow = MIX + (size_t)(rowbase + 16 * w + li) * D + 256 + qh * 64 + lq * 4;
#pragma unroll
    for (int dt = 0; dt < 4; ++dt) { u32x2 pk; pk.x = pk2(o[dt][0], o[dt][1]); pk.y = pk2(o[dt][2], o[dt][3]); *(u32x2*)(orow + 16 * dt) = pk; }
    __syncthreads();
}

__device__ __forceinline__ void retkv_unit(LAS unsigned char* lds, const Args& A, int unit, int tid) {
    asm volatile("" : "+v"(tid));
    const int c = unit & 63, h = (unit >> 6) & 3, b = unit >> 8;
    const int lane = tid & 63, w = tid >> 6, li = lane & 15, lq = lane >> 4;
    const bf16* Z = (const bf16*)(A.ws + WS_Z);
    float* KV = (float*)(A.ws + WS_KV) + (size_t)((b * 4 + h) * 64 + c) * 4096;
    LAS bf16* Kt = (LAS bf16*)lds;
    LAS bf16* Vt = (LAS bf16*)(lds + 64 * 136 * 2);
    const size_t rowbase = (size_t)b * SEQ + (size_t)c * 128;
    const float l2g = log2gamma(h);
#pragma unroll
    for (int i = 0; i < 2; ++i) {
        const int ci = tid + 512 * i, j = ci >> 3, p = ci & 7;
        const bf16* zr = Z + (rowbase + j) * INW;
        const u32x4 rk = *(const u32x4*)(zr + ZC_RK + h * 64 + p * 8), rv = *(const u32x4*)(zr + ZC_RV + h * 64 + p * 8);
        float fk[8], fv[8]; UNPACK8(rk, fk); UNPACK8(rv, fv);
        const float sc = 0.125f * exp2f((float)(127 - j) * l2g);
#pragma unroll
        for (int e = 0; e < 8; ++e) { Kt[(p * 8 + e) * 136 + j] = (bf16)f2bf(fk[e] * sc); Vt[(p * 8 + e) * 136 + j] = (bf16)f2bf(fv[e]); }
    }
    __syncthreads();
    const int dtile = w & 3, eh = w >> 2;
    f32x4 acc[2] = {(f32x4){0.f, 0.f, 0.f, 0.f}, (f32x4){0.f, 0.f, 0.f, 0.f}};
#pragma unroll
    for (int ks = 0; ks < 4; ++ks) { const bf16x8 kf = *(const LAS bf16x8*)(Kt + (16 * dtile + li) * 136 + ks * 32 + lq * 8);
#pragma unroll
        for (int n = 0; n < 2; ++n) { const bf16x8 vf = *(const LAS bf16x8*)(Vt + (16 * (eh * 2 + n) + li) * 136 + ks * 32 + lq * 8); acc[n] = MFMA16(vf, kf, acc[n]); } }
#pragma unroll
    for (int n = 0; n < 2; ++n) *(f32x4*)(KV + (16 * dtile + li) * 64 + 16 * (eh * 2 + n) + lq * 4) = acc[n];
    __syncthreads();
}

__device__ __forceinline__ void retout_unit(LAS unsigned char* lds, const Args& A, int l, int unit, int tid) {
    asm volatile("" : "+v"(tid));
    const int c = unit & 63, h = (unit >> 6) & 3, b = unit >> 8;
    const int lane = tid & 63, w = tid >> 6, li = lane & 15, lq = lane >> 4;
    const bf16* Z = (const bf16*)(A.ws + WS_Z);
    bf16* MIX = (bf16*)(A.ws + WS_MIX);
    const float* KVb = (const float*)(A.ws + WS_KV) + (size_t)((b * 4 + h) * 64) * 4096;
    LAS bf16* Qs = (LAS bf16*)lds;
    LAS bf16* Ks = (LAS bf16*)(lds + 18432);
    LAS bf16* Bt = (LAS bf16*)(lds + 36864);
    LAS bf16* P = (LAS bf16*)(lds + 62464) + w * (16 * 200);
    const size_t rowbase = (size_t)b * SEQ + (size_t)c * 128;
    const float l2g = log2gamma(h);
#pragma unroll
    for (int i = 0; i < 2; ++i) {
        const int ci = tid + 512 * i, j = ci >> 3, p = ci & 7;
        const bf16* zr = Z + (rowbase + j) * INW;
        const u32x4 rq = *(const u32x4*)(zr + ZC_RQ + h * 64 + p * 8), rk = *(const u32x4*)(zr + ZC_RK + h * 64 + p * 8), rv = *(const u32x4*)(zr + ZC_RV + h * 64 + p * 8);
        *(LAS u32x4*)(Qs + j * 72 + p * 8) = rq;
        float fk[8]; UNPACK8(rk, fk);
#pragma unroll
        for (int e = 0; e < 8; ++e) fk[e] *= 0.125f;
        *(LAS u32x4*)(Ks + j * 72 + p * 8) = PACK8(fk);
        float fv[8]; UNPACK8(rv, fv);
#pragma unroll
        for (int e = 0; e < 8; ++e) Bt[(p * 8 + e) * 200 + j] = (bf16)f2bf(fv[e]);
    }
    {
        const float g128 = exp2f(128.f * l2g);
        f32x4 s0 = (f32x4){0.f, 0.f, 0.f, 0.f}, s1 = s0;
        const float* kp = KVb + tid * 8;
        int j = 0;
        for (; j + 8 <= c; j += 8) { f32x4 a[8], bq[8];
#pragma unroll
            for (int u = 0; u < 8; ++u) { a[u] = *(const f32x4*)(kp + (size_t)(j + u) * 4096); bq[u] = *(const f32x4*)(kp + (size_t)(j + u) * 4096 + 4); }
#pragma unroll
            for (int u = 0; u < 8; ++u) { s0 = s0 * g128 + a[u]; s1 = s1 * g128 + bq[u]; } }
        for (; j < c; ++j) { const f32x4 a = *(const f32x4*)(kp + (size_t)j * 4096), bq = *(const f32x4*)(kp + (size_t)j * 4096 + 4); s0 = s0 * g128 + a; s1 = s1 * g128 + bq; }
        const int d = tid >> 3, e0 = (tid & 7) * 8;
        Bt[(e0 + 0) * 200 + 128 + d] = (bf16)f2bf(s0.x); Bt[(e0 + 1) * 200 + 128 + d] = (bf16)f2bf(s0.y); Bt[(e0 + 2) * 200 + 128 + d] = (bf16)f2bf(s0.z); Bt[(e0 + 3) * 200 + 128 + d] = (bf16)f2bf(s0.w);
        Bt[(e0 + 4) * 200 + 128 + d] = (bf16)f2bf(s1.x); Bt[(e0 + 5) * 200 + 128 + d] = (bf16)f2bf(s1.y); Bt[(e0 + 6) * 200 + 128 + d] = (bf16)f2bf(s1.z); Bt[(e0 + 7) * 200 + 128 + d] = (bf16)f2bf(s1.w);
        if (c == 63) {
            const f32x4 a = *(const f32x4*)(kp + (size_t)63 * 4096), bq = *(const f32x4*)(kp + (size_t)63 * 4096 + 4);
            float* rp = A.out + O_RETP + (size_t)((l * 2 + b) * 4 + h) * 4096 + tid * 8;
            *(f32x4*)rp = s0 * g128 + a; *(f32x4*)(rp + 4) = s1 * g128 + bq;
        }
    }
    __syncthreads();
    {
        const int i = 16 * w + li; const float qd = exp2f((float)(i + 1) * l2g);
#pragma unroll
        for (int hh = 0; hh < 2; ++hh) { const u32x4 rq = *(const LAS u32x4*)(Qs + i * 72 + lq * 16 + hh * 8); float f[8]; UNPACK8(rq, f);
#pragma unroll
            for (int e = 0; e < 8; ++e) f[e] *= qd;
            *(LAS u32x4*)(P + li * 200 + 128 + lq * 16 + hh * 8) = PACK8(f); }
    }
    bf16x8 qf[2];
#pragma unroll
    for (int kk = 0; kk < 2; ++kk) qf[kk] = *(const LAS bf16x8*)(Qs + (16 * w + li) * 72 + kk * 32 + lq * 8);
#pragma unroll
    for (int nt = 0; nt < 8; ++nt) {
        u32x2 pk = (u32x2){0u, 0u};
        if (nt <= w) {
            f32x4 acc = (f32x4){0.f, 0.f, 0.f, 0.f};
#pragma unroll
            for (int kk = 0; kk < 2; ++kk) { const bf16x8 kf = *(const LAS bf16x8*)(Ks + (16 * nt + li) * 72 + kk * 32 + lq * 8); acc = MFMA16(kf, qf[kk], acc); }
            float v[4];
#pragma unroll
            for (int r = 0; r < 4; ++r) { const int diff = 16 * w + li - 16 * nt - lq * 4 - r; v[r] = diff >= 0 ? acc[r] * exp2f((float)diff * l2g) : 0.f; }
            pk.x = pk2(v[0], v[1]); pk.y = pk2(v[2], v[3]);
        }
        *(LAS u32x2*)(P + li * 200 + 16 * nt + lq * 4) = pk;
    }
    LDS_WAIT();
    f32x4 o[4];
#pragma unroll
    for (int dt = 0; dt < 4; ++dt) o[dt] = (f32x4){0.f, 0.f, 0.f, 0.f};
#pragma unroll
    for (int ks = 0; ks < 6; ++ks) { const bf16x8 pf = *(const LAS bf16x8*)(P + li * 200 + ks * 32 + lq * 8);
#pragma unroll
        for (int dt = 0; dt < 4; ++dt) { const bf16x8 bf = *(const LAS bf16x8*)(Bt + (16 * dt + li) * 200 + ks * 32 + lq * 8); o[dt] = MFMA16(bf, pf, o[dt]); } }
    float sm = 0.f;
#pragma unroll
    for (int dt = 0; dt < 4; ++dt) sm += (o[dt][0] + o[dt][1]) + (o[dt][2] + o[dt][3]);
    sm += __shfl_xor(sm, 16); sm += __shfl_xor(sm, 32);
    const float mean = sm * (1.f / 64.f);
    float q = 0.f;
#pragma unroll
    for (int dt = 0; dt < 4; ++dt) { o[dt] = o[dt] - mean; q += (o[dt][0] * o[dt][0] + o[dt][1] * o[dt][1]) + (o[dt][2] * o[dt][2] + o[dt][3] * o[dt][3]); }
    q += __shfl_xor(q, 16); q += __shfl_xor(q, 32);
    const float rstd = rsqrtf(q * (1.f / 64.f) + EPS);
    const size_t row = rowbase + 16 * w + li;
#pragma unroll
    for (int dt = 0; dt < 4; ++dt) {
        const u32x2 rg = *(const u32x2*)(Z + row * INW + ZC_RG + h * 64 + 16 * dt + lq * 4);
        const float g0 = bflo(rg.x), g1 = bfhi(rg.x), g2 = bflo(rg.y), g3 = bfhi(rg.y);
        u32x2 pk; pk.x = pk2(o[dt][0] * rstd * g0 * sigmoidf_(g0), o[dt][1] * rstd * g1 * sigmoidf_(g1)); pk.y = pk2(o[dt][2] * rstd * g2 * sigmoidf_(g2), o[dt][3] * rstd * g3 * sigmoidf_(g3));
        *(u32x2*)(MIX + row * D + h * 64 + 16 * dt + lq * 4) = pk;
    }
    __syncthreads();
}

__device__ __forceinline__ void conf_unit(LAS unsigned char* lds, const Args& A, int l, int unit, int tid) {
    asm volatile("" : "+v"(tid));
    const int tile = unit & 255, b = unit >> 8, t0 = tile * 32;
    const int lane = tid & 63, w = tid >> 6;
    const bf16* Z = (const bf16*)(A.ws + WS_Z);
    bf16* MIX = (bf16*)(A.ws + WS_MIX);
    LAS float* U = (LAS float*)lds;
    LAS float* Y = (LAS float*)(lds + 62 * 256 * 4);
    for (int idx = tid; idx < 62 * 32; idx += NTHR) {
        const int rr = idx >> 5, p = idx & 31, t = t0 - 30 + rr;
        float u[8];
#pragma unroll
        for (int e = 0; e < 8; ++e) u[e] = 0.f;
        if (t >= 0) {
            const bf16* zr = Z + ((size_t)b * SEQ + t) * INW;
            const u32x4 ra = *(const u32x4*)(zr + ZC_CA + p * 8), rb = *(const u32x4*)(zr + ZC_CB + p * 8);
            float fa[8], fb[8]; UNPACK8(ra, fa); UNPACK8(rb, fb);
#pragma unroll
            for (int e = 0; e < 8; ++e) u[e] = fa[e] * sigmoidf_(fb[e]);
        }
        *(LAS f32x4*)(U + rr * 256 + p * 8) = (f32x4){u[0], u[1], u[2], u[3]}; *(LAS f32x4*)(U + rr * 256 + p * 8 + 4) = (f32x4){u[4], u[5], u[6], u[7]};
        if (rr >= 30 && t >= SEQ - 30) { float* cp = A.out + O_CONFP + ((size_t)(l * 2 + b) * 30 + (t - (SEQ - 30))) * 256 + p * 8;
            *(f32x4*)cp = (f32x4){u[0], u[1], u[2], u[3]}; *(f32x4*)(cp + 4) = (f32x4){u[4], u[5], u[6], u[7]}; }
    }
    __syncthreads();
    {
        const int ch = tid & 255, half = tid >> 8;
        float wv[31];
#pragma unroll
        for (int j = 0; j < 31; ++j) wv[j] = A.in[I_CDW][(size_t)(l * 31 + j) * 256 + ch];
#pragma unroll
        for (int g = 0; g < 2; ++g) {
            const int base = half * 16 + g * 8;
            float uu[38];
#pragma unroll
            for (int k = 0; k < 38; ++k) uu[k] = U[(base + k) * 256 + ch];
#pragma unroll
            for (int o = 0; o < 8; ++o) { float acc = 0.f;
#pragma unroll
                for (int j = 0; j < 31; ++j) acc += wv[j] * uu[o + j];
                Y[(base + o) * 256 + ch] = acc; }
        }
    }
    __syncthreads();
    const f32x4 lg = *(const f32x4*)(A.in[I_CLG] + l * 256 + lane * 4), lb = *(const f32x4*)(A.in[I_CLB] + l * 256 + lane * 4);
#pragma unroll
    for (int tt = 0; tt < 4; ++tt) {
        const int tok = 4 * w + tt;
        f32x4 y = *(const LAS f32x4*)(Y + tok * 256 + lane * 4);
        const float mean = wave_sum((y.x + y.y) + (y.z + y.w)) * (1.f / 256.f);
        y = y - mean;
        const float rstd = rsqrtf(wave_sum((y.x * y.x + y.y * y.y) + (y.z * y.z + y.w * y.w)) * (1.f / 256.f) + EPS);
        const f32x4 v = y * rstd * lg + lb;
        u32x2 pk; pk.x = pk2(v.x * sigmoidf_(v.x), v.y * sigmoidf_(v.y)); pk.y = pk2(v.z * sigmoidf_(v.z), v.w * sigmoidf_(v.w));
        *(u32x2*)(MIX + ((size_t)b * SEQ + t0 + tok) * D + 512 + lane * 4) = pk;
    }
    __syncthreads();
}

__device__ __forceinline__ void sconv_unit(const Args& A, int l, int unit, int tid) {
    asm volatile("" : "+v"(tid));
    const int tile = unit & 127, b = unit >> 7;
    const bf16* Z = (const bf16*)(A.ws + WS_Z);
    bf16* MIX = (bf16*)(A.ws + WS_MIX);
    const int ch0 = (tid & 31) * 8;
    float w0[8], w1[8], w2[8];
#pragma unroll
    for (int e = 0; e < 8; ++e) { w0[e] = A.in[I_SDW][(l * 3 + 0) * 256 + ch0 + e]; w1[e] = A.in[I_SDW][(l * 3 + 1) * 256 + ch0 + e]; w2[e] = A.in[I_SDW][(l * 3 + 2) * 256 + ch0 + e]; }
#pragma unroll
    for (int i = 0; i < 4; ++i) {
        const int t = tile * 64 + (tid >> 5) + 16 * i;
        const size_t row = (size_t)b * SEQ + t;
        float g[3][8];
#pragma unroll
        for (int k = 0; k < 3; ++k) {
#pragma unroll
            for (int e = 0; e < 8; ++e) g[k][e] = 0.f;
            if (t - k >= 0) { const bf16* zr = Z + (row - k) * INW; const u32x4 rc = *(const u32x4*)(zr + ZC_SC + ch0), rh = *(const u32x4*)(zr + ZC_SH + ch0);
                float fc[8], fh[8]; UNPACK8(rc, fc); UNPACK8(rh, fh);
#pragma unroll
                for (int e = 0; e < 8; ++e) g[k][e] = fc[e] * fh[e]; }
        }
        const u32x4 rb = *(const u32x4*)(Z + row * INW + ZC_SB + ch0);
        float fb[8], o[8]; UNPACK8(rb, fb);
#pragma unroll
        for (int e = 0; e < 8; ++e) o[e] = fb[e] * (w0[e] * g[2][e] + w1[e] * g[1][e] + w2[e] * g[0][e]);
        *(u32x4*)(MIX + row * D + 768 + ch0) = PACK8(o);
        if (t >= SEQ - 2) { float* sp = A.out + O_SCP + ((size_t)(l * 2 + b) * 2 + (t - (SEQ - 2))) * 256 + ch0;
            *(f32x4*)sp = (f32x4){g[0][0], g[0][1], g[0][2], g[0][3]}; *(f32x4*)(sp + 4) = (f32x4){g[0][4], g[0][5], g[0][6], g[0][7]}; }
    }
}

__device__ __forceinline__ void sample_unit(LAS unsigned char* lds, const Args& A, int l, int b, int tid) {
    asm volatile("" : "+v"(tid));
    const int lane = tid & 63, w = tid >> 6;
    const bf16* Z = (const bf16*)(A.ws + WS_Z);
    bf16* MIX = (bf16*)(A.ws + WS_MIX);
    LAS float* Zs = (LAS float*)lds;
    LAS float* KD = (LAS float*)(lds + 90112);
    LAS float* Qn = (LAS float*)(lds + 98304);
    LAS float* Kn = (LAS float*)(lds + 106496);
    LAS float* Sc = (LAS float*)(lds + 110592);
    LAS float* Y = Sc;
    LAS float* PART = (LAS float*)(lds + 128000);
    LAS float* ATT = (LAS float*)(lds + 144384);
    const size_t row0 = (size_t)TP + (size_t)b * 8;
    const size_t lb = (size_t)l * 128 + b;
    for (int idx = tid; idx < 8 * 352; idx += NTHR) { const int r = idx / 352, p = idx % 352;
        const u32x4 raw = *(const u32x4*)(Z + (row0 + r) * INW + p * 8); float f[8]; UNPACK8(raw, f);
        *(LAS f32x4*)(Zs + r * INW + p * 8) = (f32x4){f[0], f[1], f[2], f[3]}; *(LAS f32x4*)(Zs + r * INW + p * 8 + 4) = (f32x4){f[4], f[5], f[6], f[7]}; }
    __syncthreads();
    if (tid < 256) {
        const int ch = tid;
        float xp[10];
        xp[0] = A.in[I_SSC][(lb * 2 + 0) * 256 + ch]; xp[1] = A.in[I_SSC][(lb * 2 + 1) * 256 + ch];
#pragma unroll
        for (int t = 0; t < 8; ++t) xp[2 + t] = Zs[t * INW + ZC_SC + ch] * Zs[t * INW + ZC_SH + ch];
        const float w0 = A.in[I_SDW][(l * 3 + 0) * 256 + ch], w1 = A.in[I_SDW][(l * 3 + 1) * 256 + ch], w2 = A.in[I_SDW][(l * 3 + 2) * 256 + ch];
#pragma unroll
        for (int t = 0; t < 8; ++t) { const float y = w0 * xp[t] + w1 * xp[t + 1] + w2 * xp[t + 2];
            MIX[(row0 + t) * D + 768 + ch] = (bf16)f2bf(Zs[t * INW + ZC_SB + ch] * y); }
        A.out[O_SCS + (lb * 2 + 0) * 256 + ch] = xp[8]; A.out[O_SCS + (lb * 2 + 1) * 256 + ch] = xp[9];
    } else {
        const int ch = tid - 256;
        float xp[38];
#pragma unroll
        for (int k = 0; k < 30; ++k) xp[k] = A.in[I_SCONF][(lb * 30 + k) * 256 + ch];
#pragma unroll
        for (int t = 0; t < 8; ++t) xp[30 + t] = Zs[t * INW + ZC_CA + ch] * sigmoidf_(Zs[t * INW + ZC_CB + ch]);
        float acc[8];
#pragma unroll
        for (int t = 0; t < 8; ++t) acc[t] = 0.f;
#pragma unroll
        for (int j = 0; j < 31; ++j) { const float wj = A.in[I_CDW][(size_t)(l * 31 + j) * 256 + ch];
#pragma unroll
            for (int t = 0; t < 8; ++t) acc[t] += wj * xp[t + j]; }
#pragma unroll
        for (int t = 0; t < 8; ++t) Y[t * 256 + ch] = acc[t];
#pragma unroll
        for (int i = 0; i < 30; ++i) A.out[O_CONFS + (lb * 30 + i) * 256 + ch] = xp[8 + i];
    }
#pragma unroll
    for (int i = 0; i < 6; ++i) {
        const int v = w * 6 + i;
        if (v < 32) { const int t = v >> 2, h = v & 3; const float x = Zs[t * INW + ZC_AQ + h * 64 + lane];
            const float rs = rsqrtf(wave_sum(x * x) * (1.f / 64.f) + EPS) * 0.125f; Qn[t * 256 + h * 64 + lane] = x * rs * A.in[I_QG][l * 64 + lane]; }
        else { const int v2 = v - 32, t = v2 >> 1, kh = v2 & 1; const float x = Zs[t * INW + ZC_AK + kh * 64 + lane];
            const float rs = rsqrtf(wave_sum(x * x) * (1.f / 64.f) + EPS); Kn[t * 128 + kh * 64 + lane] = x * rs * A.in[I_KG][l * 64 + lane]; }
    }
#pragma unroll
    for (int i = 0; i < 4; ++i) { const int idx = tid + 512 * i, j = idx >> 8, c = idx & 255;
        KD[idx] = Zs[j * INW + ZC_RK + c] * 0.125f * exp2f((float)(7 - j) * log2gamma(c >> 6)); }
    if (tid < 256) { const int h = tid >> 6, i = (tid >> 3) & 7, j = tid & 7;
        float dot = 0.f;
        for (int d = 0; d < 64; ++d) dot += Zs[i * INW + ZC_RQ + h * 64 + d] * Zs[j * INW + ZC_RK + h * 64 + d];
        ATT[tid] = (j <= i) ? dot * 0.125f * exp2f((float)(i - j) * log2gamma(h)) : 0.f; }
    __syncthreads();
    {
        const f32x4 lg = *(const f32x4*)(A.in[I_CLG] + l * 256 + lane * 4), lbv = *(const f32x4*)(A.in[I_CLB] + l * 256 + lane * 4);
        f32x4 y = *(const LAS f32x4*)(Y + w * 256 + lane * 4);
        const float mean = wave_sum((y.x + y.y) + (y.z + y.w)) * (1.f / 256.f);
        y = y - mean;
        const float rstd = rsqrtf(wave_sum((y.x * y.x + y.y * y.y) + (y.z * y.z + y.w * y.w)) * (1.f / 256.f) + EPS);
        const f32x4 v = y * rstd * lg + lbv;
        u32x2 pk; pk.x = pk2(v.x * sigmoidf_(v.x), v.y * sigmoidf_(v.y)); pk.y = pk2(v.z * sigmoidf_(v.z), v.w * sigmoidf_(v.w));
        *(u32x2*)(MIX + (row0 + w) * D + 512 + lane * 4) = pk;
    }
    {
        const int h = tid >> 7, e = tid & 63, dh = (tid >> 6) & 1;
        const float l2g = log2gamma(h), cdec = exp2f(8.f * l2g);
        float v[8], accq[8];
#pragma unroll
        for (int j = 0; j < 8; ++j) { v[j] = Zs[j * INW + ZC_RV + h * 64 + e]; accq[j] = 0.f; }
        const float* sp = A.in[I_SRET] + ((lb * 4 + h) * 64 + dh * 32) * 64 + e;
        float* op = A.out + O_RETS + ((lb * 4 + h) * 64 + dh * 32) * 64 + e;
#pragma unroll 16
        for (int dd = 0; dd < 32; ++dd) {
            const int d = dh * 32 + dd;
            const float s = sp[dd * 64];
            float sn = s * cdec;
#pragma unroll
            for (int t = 0; t < 8; ++t) { accq[t] += Zs[t * INW + ZC_RQ + h * 64 + d] * s; sn += KD[t * 256 + h * 64 + d] * v[t]; }
            op[dd * 64] = sn;
        }
#pragma unroll
        for (int t = 0; t < 8; ++t) PART[((h * 2 + dh) * 8 + t) * 64 + e] = accq[t];
    }
    __syncthreads();
    {
        const int h = tid >> 7, e = tid & 63, tg = (tid >> 6) & 1;
        const float l2g = log2gamma(h);
#pragma unroll
        for (int tt = 0; tt < 4; ++tt) {
            const int t = tg * 4 + tt;
            float o = exp2f((float)(t + 1) * l2g) * (PART[((h * 2) * 8 + t) * 64 + e] + PART[((h * 2 + 1) * 8 + t) * 64 + e]);
#pragma unroll
            for (int j = 0; j < 8; ++j) o += ATT[h * 64 + t * 8 + j] * Zs[j * INW + ZC_RV + h * 64 + e];
            const float mean = wave_sum(o) * (1.f / 64.f);
            o -= mean;
            const float rstd = rsqrtf(wave_sum(o * o) * (1.f / 64.f) + EPS);
            const float g = Zs[t * INW + ZC_RG + h * 64 + e];
            MIX[(row0 + t) * D + h * 64 + e] = (bf16)f2bf(o * rstd * g * sigmoidf_(g));
        }
    }
    {
        const int kvh = tid >> 8, j = tid & 255;
        if (j < 136) {
            float key[64];
            if (j < 128) { const float* kp = A.in[I_CK] + ((lb * 128 + j) * 2 + kvh) * 64;
#pragma unroll
                for (int d4 = 0; d4 < 16; ++d4) { const f32x4 kv = *(const f32x4*)(kp + d4 * 4); key[d4 * 4] = kv.x; key[d4 * 4 + 1] = kv.y; key[d4 * 4 + 2] = kv.z; key[d4 * 4 + 3] = kv.w; } }
            else {
#pragma unroll
                for (int d4 = 0; d4 < 16; ++d4) { const f32x4 kv = *(const LAS f32x4*)(Kn + (j - 128) * 128 + kvh * 64 + d4 * 4); key[d4 * 4] = kv.x; key[d4 * 4 + 1] = kv.y; key[d4 * 4 + 2] = kv.z; key[d4 * 4 + 3] = kv.w; } }
#pragma unroll 1
            for (int gt = 0; gt < 16; ++gt) {
                const int g = gt >> 3, t = gt & 7, head = kvh * 2 + g;
                float dot = 0.f;
#pragma unroll
                for (int d4 = 0; d4 < 16; ++d4) { const f32x4 q = *(const LAS f32x4*)(Qn + t * 256 + head * 64 + d4 * 4);
                    dot += q.x * key[d4 * 4] + q.y * key[d4 * 4 + 1] + q.z * key[d4 * 4 + 2] + q.w * key[d4 * 4 + 3]; }
                const int dist = t + 128 - j;
                const float slope = exp2f(-2.f * (float)(head + 1));
                Sc[(kvh * 16 + gt) * 136 + j] = (dist >= 0 && dist <= 128) ? dot - slope * (float)dist : -INFINITY;
            }
        }
#pragma unroll
        for (int k = 0; k < 8; ++k) { const int idx4 = tid + 512 * k, i = idx4 >> 5, c4 = (idx4 & 31) * 4;
            f32x4 kk, vv;
            if (i < 120) { kk = *(const f32x4*)(A.in[I_CK] + (lb * 128 + i + 8) * 128 + c4); vv = *(const f32x4*)(A.in[I_CV] + (lb * 128 + i + 8) * 128 + c4); }
            else { kk = *(const LAS f32x4*)(Kn + (i - 120) * 128 + c4); vv = *(const LAS f32x4*)(Zs + (i - 120) * INW + ZC_AV + c4); }
            *(f32x4*)(A.out + O_KS + (lb * 128 + i) * 128 + c4) = kk; *(f32x4*)(A.out + O_VS + (lb * 128 + i) * 128 + c4) = vv; }
    }
    __syncthreads();
#pragma unroll
    for (int rr = 0; rr < 4; ++rr) {
        const int row = 4 * w + rr, head = (row >> 4) * 2 + ((row >> 3) & 1);
        const float sink = A.in[I_SINK][l * 4 + head];
        const float v0 = Sc[row * 136 + lane], v1 = Sc[row * 136 + 64 + lane], v2 = (lane < 8) ? Sc[row * 136 + 128 + lane] : -INFINITY;
        const float mx = fmaxf(wave_max(fmaxf(fmaxf(v0, v1), v2)), sink);
        const float p0 = __expf(v0 - mx), p1 = __expf(v1 - mx), p2 = __expf(v2 - mx);
        const float inv = 1.f / (wave_sum(p0 + p1 + p2) + __expf(sink - mx));
        Sc[row * 136 + lane] = p0 * inv; Sc[row * 136 + 64 + lane] = p1 * inv; if (lane < 8) Sc[row * 136 + 128 + lane] = p2 * inv;
    }
    __syncthreads();
    {
        const int kvh = tid >> 8, d = tid & 63, rg = (tid >> 6) & 3;
        float acc[4] = {0.f, 0.f, 0.f, 0.f};
        const float* vp = A.in[I_CV] + (lb * 128 * 2 + kvh) * 64 + d;
#pragma unroll 16
        for (int j = 0; j < 128; ++j) { const float v = vp[(size_t)j * 128];
#pragma unroll
            for (int rr = 0; rr < 4; ++rr) acc[rr] += Sc[(kvh * 16 + rg * 4 + rr) * 136 + j] * v; }
#pragma unroll
        for (int j = 0; j < 8; ++j) { const float v = Zs[j * INW + ZC_AV + kvh * 64 + d];
#pragma unroll
            for (int rr = 0; rr < 4; ++rr) acc[rr] += Sc[(kvh * 16 + rg * 4 + rr) * 136 + 128 + j] * v; }
#pragma unroll
        for (int rr = 0; rr < 4; ++rr) { const int r16 = rg * 4 + rr, g = r16 >> 3, t = r16 & 7;
            MIX[(row0 + t) * D + 256 + (kvh * 2 + g) * 64 + d] = (bf16)f2bf(acc[rr]); }
    }
    __syncthreads();
}

#define XB_TMO      128
#define XB_XCNT(j)  (256  + 64 * (j))
#define XB_XSUB(j)  (1280 + 64 * (j))
#define XB_XGEN(j)  (2304 + 64 * (j))
#define XB_TOP      3328
#define XB_TOPGEN   3392
#define XCD_BAR_WORDS 3456
#define XB_SPIN_CAP (1u << 18)

__device__ __forceinline__ unsigned xb_ld(unsigned* p)              { return __hip_atomic_load(p, __ATOMIC_RELAXED, __HIP_MEMORY_SCOPE_AGENT); }
__device__ __forceinline__ unsigned xb_add(unsigned* p, unsigned v) { return __hip_atomic_fetch_add(p, v, __ATOMIC_RELAXED, __HIP_MEMORY_SCOPE_AGENT); }
__device__ __forceinline__ unsigned xb_xcc_id() { return (unsigned)__builtin_amdgcn_s_getreg((3 << 11) | 20) & 0xFu; }
#define XB_SPIN(cond, bar) do { unsigned _sp = 0; while (cond) { __builtin_amdgcn_s_sleep(1); \
    if ((++_sp & 255u) == 0u) { if (xb_ld(&(bar)[XB_TMO])) break; if (_sp > XB_SPIN_CAP) { atomicAdd(&(bar)[XB_TMO], 1u); break; } } } } while (0)

struct XcdBarrier {
    unsigned* bar; unsigned x;
    volatile LAS unsigned* st;
};

__device__ __forceinline__ XcdBarrier xcd_barrier_post(unsigned* bar, volatile LAS unsigned* st) {
    XcdBarrier b; b.bar = bar; b.x = xb_xcc_id(); b.st = st;
    if (threadIdx.x == 0) (void)xb_add(&bar[XB_XCNT(b.x)], 1u);
    return b;
}
__device__ __forceinline__ void xcd_barrier_complete(unsigned* bar, unsigned x, unsigned& nloc, unsigned& nx) {
    const unsigned G = gridDim.x * gridDim.y * gridDim.z;
    unsigned sum, cnt, mine, sp = 0u;
    for (;;) {
        sum = 0u; cnt = 0u; mine = 0u;
#pragma unroll
        for (unsigned j = 0; j < 16; ++j) { const unsigned c = xb_ld(&bar[XB_XCNT(j)]); sum += c; cnt += (c > 0u) ? 1u : 0u; mine = (j == x) ? c : mine; }
        if (sum == G) break;
        __builtin_amdgcn_s_sleep(1);
        if ((++sp & 255u) == 0u) { if (xb_ld(&bar[XB_TMO])) break; if (sp > XB_SPIN_CAP) { atomicAdd(&bar[XB_TMO], 1u); break; } }
    }
    nloc = mine > 0u ? mine : 1u; nx = cnt > 0u ? cnt : 1u;
}

__device__ __forceinline__ void xcd_barrier(const XcdBarrier& b) {
    asm volatile("s_waitcnt vmcnt(0)" ::: "memory");
    __syncthreads();
    if (threadIdx.x == 0) {
        unsigned* bar = b.bar;
        __builtin_amdgcn_s_waitcnt(0);
        unsigned nloc = b.st[0], nx = b.st[1];
        if (nloc == 0u) { xcd_barrier_complete(bar, b.x, nloc, nx); b.st[0] = nloc; b.st[1] = nx; }
        const unsigned old = xb_add(&bar[XB_XSUB(b.x)], 1u);
        const unsigned gen = old / nloc;
        if (old + 1u == (gen + 1u) * nloc) {
            __builtin_amdgcn_fence(__ATOMIC_RELEASE, "agent");
            asm volatile("s_waitcnt vmcnt(0)" ::: "memory");
            const unsigned og = xb_add(&bar[XB_TOP], 1u);
            const unsigned tg = og / nx;
            if (og + 1u == (tg + 1u) * nx) xb_add(&bar[XB_TOPGEN], 1u);
            else XB_SPIN(xb_ld(&bar[XB_TOPGEN]) == tg, bar);
            __builtin_amdgcn_fence(__ATOMIC_ACQUIRE, "agent");
            xb_add(&bar[XB_XGEN(b.x)], 1u);
            asm volatile("s_waitcnt vmcnt(0)" ::: "memory");
        } else {
            XB_SPIN(xb_ld(&bar[XB_XGEN(b.x)]) == gen, bar);
            __builtin_amdgcn_fence(__ATOMIC_ACQUIRE, "agent");
            asm volatile("s_waitcnt vmcnt(0)" ::: "memory");
        }
    }
    __syncthreads();
}

__global__ void __launch_bounds__(NTHR) fwd_megakernel(Args Akarg) {
    typedef const __attribute__((address_space(4))) Args* KArgP;
    KArgP kp0 = (KArgP)__builtin_amdgcn_kernarg_segment_ptr();
    (void)Akarg;
    unsigned char* const ws0 = kp0->ws;
    extern __shared__ __attribute__((aligned(16))) unsigned char lds_raw[];
    LAS unsigned char* lds = (LAS unsigned char*)lds_raw;
    cg::grid_group grid = cg::this_grid();
    const int tid = threadIdx.x;
    const int G = gridDim.x, bx = blockIdx.x;

#ifndef PHMASK
#define PHMASK 0xFFFF
#endif
    if (tid < 16) ((LAS unsigned*)(lds + LDS_BYTES - 64))[tid] = 0u;
    __syncthreads();
    XcdBarrier bar = xcd_barrier_post((unsigned*)(ws0 + WS_CTL), (volatile LAS unsigned*)(lds + LDS_BYTES - 64));
    if (ws0 == nullptr) grid.sync();
#define GRID_BAR() xcd_barrier(bar)
#pragma unroll 1
    for (int ph = 0; ph < 18; ++ph) {
        const int l = (ph - 1) >> 3, s = (ph - 1) & 7;
        KArgP kpl = kp0; asm volatile("" : "+s"(kpl));
#if defined(__HIP_DEVICE_COMPILE__)
        const Args A = *kpl;
#else
        const Args A = Akarg;
#endif
        bf16* XN = (bf16*)(A.ws + WS_XN); bf16* Zb = (bf16*)(A.ws + WS_Z); bf16* MIX = (bf16*)(A.ws + WS_MIX); bf16* Hb = (bf16*)(A.ws + WS_H);
        const float* mod = (const float*)(A.ws + WS_MOD) + (size_t)(l < 0 ? 0 : (l >= NL ? NL - 1 : l)) * NMODR * MODW;
        if (ph == 0) { if (PHMASK & 1) p0_prologue(lds, A, tid); }
        else if (s == 0) { if (PHMASK & 2) norm_phase(A, l, 0, tid); if (l == NL) break; }
        else if (s == 1) { if (PHMASK & 4) {
            pg8::Gemm g{XN, (const bf16*)(A.ws + WS_WIN) + (size_t)l * INW * D, T, INW, D, D}; pg8::StaticOrder S; S.init(T, INW, G, bx);
            pg8::EpiBf16<0> E{Zb, INW};
            pg8::gemm_phase<pg8::EpiBf16<0>, pg8::StaticOrder, true, true>(lds, g, S, E); } }
        else if (s == 2) {
            unsigned* qc = (unsigned*)(A.ws + WS_CTL) + 3584 + 64 * l;
            const int total = (l == 0) ? 1920 + TR_PER_L / 8 : 1920;
            int cur = bx;
            while (cur < total) {
                unsigned nxt = 0u; if (tid == 0) nxt = __hip_atomic_fetch_add(qc, 1u, __ATOMIC_RELAXED, __HIP_MEMORY_SCOPE_AGENT) + (unsigned)G;
                if (cur < 128) { if (PHMASK & 8) sample_unit(lds, A, l, cur, tid); }
                else if (cur < 640) { if (PHMASK & 16) attn_unit(lds, A, l, cur - 128, tid); }
                else if (cur < 1152) { if (PHMASK & 32) conf_unit(lds, A, l, cur - 640, tid); }
                else if (cur < 1664) { if (PHMASK & 64) retkv_unit(lds, A, cur - 1152, tid); }
                else if (cur < 1920) { if (PHMASK & 128) sconv_unit(A, l, cur - 1664, tid); }
                else { int t2 = tid; asm volatile("" : "+v"(t2)); const int wv = t2 >> 6; transpose_dispatch(A, TR_PER_L + (cur - 1920) * 8 + wv, (LAS float*)(lds + wv * 16384), t2 & 63); }
                volatile LAS unsigned* qs = (volatile LAS unsigned*)(lds + LDS_BYTES - 64);
                if (tid == 0) qs[2] = nxt;
                __syncthreads(); cur = (int)qs[2]; __syncthreads();
            } }
        else if (s == 3) { if (PHMASK & 256) {
            unsigned* qc = (unsigned*)(A.ws + WS_CTL) + 3584 + 64 * (2 + l);
            int cur = bx;
            while (cur < 512) {
                unsigned nxt = 0u; if (tid == 0) nxt = __hip_atomic_fetch_add(qc, 1u, __ATOMIC_RELAXED, __HIP_MEMORY_SCOPE_AGENT) + (unsigned)G;
                retout_unit(lds, A, l, ((cur & 7) << 6) | (63 - (cur >> 3)), tid);
                volatile LAS unsigned* qs = (volatile LAS unsigned*)(lds + LDS_BYTES - 64);
                if (tid == 0) qs[2] = nxt;
                __syncthreads(); cur = (int)qs[2]; __syncthreads();
            } } }
        else if (s == 4) { if (PHMASK & 512) {
            pg8::Gemm g{MIX, (const bf16*)(A.ws + WS_WOUT) + (size_t)l * D * D, T, D, D, D}; pg8::StaticOrder S; S.init(TP, D, G, bx);
            pg8::EpiRes E{l == 0 ? A.in[I_XP] : A.out, l == 0 ? A.in[I_XS] : A.out + (size_t)TP * D, A.out, mod + 2 * D, D, TP, MODW};
            pg8::gemm_phase<pg8::EpiRes, pg8::StaticOrder, true, true>(lds, g, S, E);
            pg8::Gemm g2{MIX, (const bf16*)(A.ws + WS_WOUT) + (size_t)l * D * D, T, D, 256, D}; pg8::SplitOrder S2{TP / 256, TS / 256, D / 256, 4, G, bx};
            pg8::EpiPart E2{(float*)(A.ws + WS_P2), TP, TS, D};
            pg8::gemm_phase<pg8::EpiPart, pg8::SplitOrder, true, true>(lds, g2, S2, E2); } }
        else if (s == 5) { if (PHMASK & 2) norm_phase(A, l, 1, tid); }
        else if (s == 6) { if (PHMASK & 1024) {
            pg8::Gemm g{XN, (const bf16*)(A.ws + WS_W1) + (size_t)l * FF * D, T, FF, D, D}; pg8::StaticOrder S; S.init(T, FF, G, bx);
            pg8::EpiBf16<2> E{Hb, FF};
            pg8::gemm_phase<pg8::EpiBf16<2>, pg8::StaticOrder, true, true>(lds, g, S, E); } }
        else { if (PHMASK & 2048) {
            pg8::Gemm g{Hb, (const bf16*)(A.ws + WS_W2) + (size_t)l * D * FF, T, D, FF, FF}; pg8::StaticOrder S; S.init(TP, D, G, bx);
            pg8::EpiRes E{A.out, A.out + (size_t)TP * D, A.out, mod + 5 * D, D, TP, MODW};
            pg8::gemm_phase<pg8::EpiRes, pg8::StaticOrder, true, true>(lds, g, S, E);
            pg8::Gemm g2{Hb, (const bf16*)(A.ws + WS_W2) + (size_t)l * D * FF, T, D, 512, FF}; pg8::SplitOrder S2{TP / 256, TS / 256, D / 256, 8, G, bx};
            pg8::EpiPart E2{(float*)(A.ws + WS_P4), TP, TS, D};
            pg8::gemm_phase<pg8::EpiPart, pg8::SplitOrder, true, true>(lds, g2, S2, E2); } }
        if (ph < 17) GRID_BAR();
    }
}

extern "C" void kernel_launch(void* const* d_in, const int* in_sizes, int n_in, void* d_out, int out_size, void* d_ws, size_t ws_size, hipStream_t stream) {
    static int grid = 0;
    if (grid == 0) {
        if (n_in != 24 || (size_t)out_size != O_END || ws_size < WS_END) { fprintf(stderr, "kernel_launch: unexpected shapes n_in %d out %d ws %zu\n", n_in, out_size, ws_size); grid = -1; return; }
        int dev = 0, cus = 0, per_cu = 0;
        hipGetDevice(&dev); hipDeviceGetAttribute(&cus, hipDeviceAttributeMultiprocessorCount, dev);
        hipFuncSetAttribute((const void*)fwd_megakernel, hipFuncAttributeMaxDynamicSharedMemorySize, LDS_BYTES);
        hipOccupancyMaxActiveBlocksPerMultiprocessor(&per_cu, (const void*)fwd_megakernel, NTHR, LDS_BYTES);
        if (per_cu < 1) { fprintf(stderr, "kernel_launch: occupancy query says %d blocks per CU\n", per_cu); per_cu = 1; }
        grid = cus;
        (void)hipGetLastError();
    }
    if (grid < 0) return;
    if (hipMemsetAsync((char*)d_ws + WS_CTL, 0, CTL_BYTES, stream) != hipSuccess) { fprintf(stderr, "memset failed\n"); return; }
    Args a{};
    for (int i = 0; i < 24; ++i) a.in[i] = (const float*)d_in[i];
    a.out = (float*)d_out; a.ws = (unsigned char*)d_ws;
    void* args[] = {&a};
    hipError_t e = hipLaunchCooperativeKernel((const void*)fwd_megakernel, dim3(grid), dim3(NTHR), args, LDS_BYTES, stream);
    if (e != hipSuccess) fprintf(stderr, "cooperative launch failed: %s (grid %d)\n", hipGetErrorString(e), grid);
}
```
